# Optimizing an MI355X kernel written in HIP

```python
import jax, jax.numpy as jnp
from jax import lax
import numpy as np

D_MODEL = 2048
BATCH = 4
SEQ = 4096
DEPTH = 2

GRID_W = 64
CTX_LEN = 256
HEAD_DIM = 64
RWKV_HEADS = D_MODEL // (2 * HEAD_DIM)
RWKV_DIM = RWKV_HEADS * HEAD_DIM
DECAY_LORA = 64
ICLR_LORA = 64
GATE_LORA = 160
RWKV_COLS = 3 * RWKV_DIM + 2 * DECAY_LORA + 2 * ICLR_LORA + GATE_LORA
GQA_Q_HEADS = D_MODEL // (2 * HEAD_DIM)
GQA_KV_HEADS = GQA_Q_HEADS // 4
GQA_COLS = (GQA_Q_HEADS + 2 * GQA_KV_HEADS) * HEAD_DIM
IN_COLS_AB = GQA_COLS + RWKV_COLS
OUT_COLS_AB = GQA_Q_HEADS * HEAD_DIM + RWKV_DIM
NA_HEADS = D_MODEL // HEAD_DIM
NA_ROWS_MAX = 8
NA_COLS = 16
D_FF = 4 * D_MODEL
Q_BLOCK = 128
ROPE_THETA = 10000.0
ROPE_PAIRS_PER_AXIS = HEAD_DIM // 4
NORM_EPS = 1e-6
LNX_EPS = 64e-5

kernel_name = 'hybrid_dit_rwkv7_gqa_natten'


def _split(t, sizes):
    return jnp.split(t, [int(s) for s in np.cumsum(sizes)[:-1]], axis=-1)


def _heads(t, n_heads):
    return t.reshape(t.shape[:-1] + (n_heads, t.shape[-1] // n_heads))


def _rms_norm(x, g):
    xf = x.astype(jnp.float32)
    y = xf * lax.rsqrt(jnp.mean(xf * xf, axis=-1, keepdims=True) + NORM_EPS)
    return (y * g.astype(jnp.float32)).astype(x.dtype)


def _modulate(h, shift, scale):
    return h * (1.0 + scale) + shift


def _sq_relu_mlp(h, w1, w2):
    return jnp.square(jax.nn.relu(h @ w1)) @ w2


def _qshift_grid(p):
    b, t, ch = p.shape
    rows = t // GRID_W
    p4 = p.reshape(b, rows, GRID_W, ch // 4, 4)
    from_left = jnp.pad(p4[..., 0], ((0, 0), (0, 0), (1, 0), (0, 0)))[:, :, :-1]
    from_right = jnp.pad(p4[..., 1], ((0, 0), (0, 0), (0, 1), (0, 0)))[:, :, 1:]
    from_up = jnp.pad(p4[..., 2], ((0, 0), (1, 0), (0, 0), (0, 0)))[:, :-1]
    from_down = jnp.pad(p4[..., 3], ((0, 0), (0, 1), (0, 0), (0, 0)))[:, 1:]
    return jnp.stack([from_left, from_right, from_up, from_down], axis=-1).reshape(b, t, ch)


def _shift_seq(p):
    b, t, ch = p.shape
    p2 = p.reshape(b, t, ch // 2, 2)
    prev = jnp.pad(p2[..., 0], ((0, 0), (1, 0), (0, 0)))[:, :-1]
    nxt = jnp.pad(p2[..., 1], ((0, 0), (0, 1), (0, 0)))[:, 1:]
    return jnp.stack([prev, nxt], axis=-1).reshape(b, t, ch)


def _axial_rope(n):
    t = jnp.arange(n, dtype=jnp.int32)
    row = (t // GRID_W).astype(jnp.float32)
    col = (t % GRID_W).astype(jnp.float32)
    inv = ROPE_THETA ** (-jnp.arange(ROPE_PAIRS_PER_AXIS, dtype=jnp.float32) / ROPE_PAIRS_PER_AXIS)
    ang = jnp.concatenate([row[:, None] * inv, col[:, None] * inv], axis=-1)
    return jnp.cos(ang), jnp.sin(ang)


def _rope(x, cos, sin):
    half = x.shape[-1] // 2
    xf = x.astype(jnp.float32)
    x1, x2 = xf[..., :half], xf[..., half:]
    cs, sn = cos[None, :, None, :], sin[None, :, None, :]
    return jnp.concatenate([x1 * cs - x2 * sn, x2 * cs + x1 * sn], axis=-1).astype(x.dtype)


def _gqa_dense(q5, k, v):
    s = jnp.einsum('bqkgd,bskd->bkgqs', q5, k).astype(jnp.float32)
    p = jax.nn.softmax(s, axis=-1).astype(v.dtype)
    return jnp.einsum('bkgqs,bskd->bqkgd', p, v)


def _gqa_blocks(q, k, v):
    b, t, hq, dh = q.shape
    hkv = k.shape[2]
    nb = t // Q_BLOCK
    qb = q.reshape(b, nb, Q_BLOCK, hkv, hq // hkv, dh).transpose(1, 0, 2, 3, 4, 5)
    o = lax.map(lambda qi: _gqa_dense(qi, k, v), qb)
    return o.transpose(1, 0, 2, 3, 4, 5).reshape(b, t, hq * dh)


def _rwkv7_scan(r, decay, k, v, a, b, s0, reverse):
    def step(s, inp):
        r_t, w_t, k_t, v_t, a_t, b_t = inp
        sa = jnp.einsum('bhij,bhj->bhi', s, a_t)
        s = s * w_t[:, :, None, :] + sa[..., None] * b_t[:, :, None, :] + v_t[..., None] * k_t[:, :, None, :]
        return s, jnp.einsum('bhij,bhj->bhi', s, r_t)
    xs = tuple(jnp.moveaxis(t, 1, 0) for t in (r, decay, k, v, a, b))
    s_final, ys = lax.scan(step, s0, xs, reverse=reverse)
    return jnp.moveaxis(ys, 0, 1), s_final


def _rwkv7_prep(xm, w0_f, w0_b, ww2_f, ww2_b, a0_f, a0_b, wa2_f, wa2_b, wg2, k_k, k_a, r_k):
    f32 = jnp.float32
    r, k, v, xw_f, xw_b, xa_f, xa_b, xg = _split(
        xm, (RWKV_DIM,) * 3 + (DECAY_LORA,) * 2 + (ICLR_LORA,) * 2 + (GATE_LORA,))
    kk = _heads((k * k_k).astype(f32), RWKV_HEADS)
    kk = kk * lax.rsqrt(jnp.maximum(jnp.sum(kk * kk, axis=-1, keepdims=True), 1e-12))
    rh = _heads(r.astype(f32), RWKV_HEADS)
    vh = _heads(v.astype(f32), RWKV_HEADS)
    dirs = []
    for w0, ww2, a0, wa2, xw, xa in ((w0_f, ww2_f, a0_f, wa2_f, xw_f, xa_f),
                                     (w0_b, ww2_b, a0_b, wa2_b, xw_b, xa_b)):
        log_w = -jax.nn.softplus(-(w0 + jnp.tanh(xw) @ ww2).astype(f32)) - 0.5
        decay = jnp.exp(-jnp.exp(log_w))
        iclr = jax.nn.sigmoid((a0 + xa @ wa2).astype(f32))
        k_dir = _heads(k.astype(f32) * (1.0 + (iclr - 1.0) * k_a), RWKV_HEADS)
        iclr = _heads(iclr, RWKV_HEADS)
        bonus = jnp.sum(rh * k_dir * r_k, axis=-1, keepdims=True) * vh
        dirs.append((_heads(decay, RWKV_HEADS), k_dir, -kk, kk * iclr, bonus))
    gate = jax.nn.sigmoid(xg) @ wg2
    return rh, vh, dirs, gate


def _rwkv7_bidirectional(xm_lat, xm_ctx, w0_f, w0_b, ww2_f, ww2_b, a0_f, a0_b, wa2_f, wa2_b,
                         wg2, k_k, k_a, r_k, lnx_g, lnx_b):
    r_l, v_l, dirs_l, gate_l = _rwkv7_prep(xm_lat, w0_f, w0_b, ww2_f, ww2_b, a0_f, a0_b, wa2_f, wa2_b, wg2, k_k, k_a, r_k)
    r_c, v_c, dirs_c, gate_c = _rwkv7_prep(xm_ctx, w0_f, w0_b, ww2_f, ww2_b, a0_f, a0_b, wa2_f, wa2_b, wg2, k_k, k_a, r_k)
    s0 = jnp.zeros(r_c.shape[:1] + (RWKV_HEADS, HEAD_DIM, HEAD_DIM), jnp.float32)
    ys_l = []
    ys_c = []
    for dl, dc, reverse in zip(dirs_l, dirs_c, (False, True)):
        y_c, s_ctx = _rwkv7_scan(r_c, dc[0], dc[1], v_c, dc[2], dc[3], s0, reverse)
        y_l, _ = _rwkv7_scan(r_l, dl[0], dl[1], v_l, dl[2], dl[3], s_ctx, reverse)
        ys_l.append(y_l)
        ys_c.append(y_c)

    def finish(ys, dirs, gate, dtype):
        y = ys[0] + ys[1]
        mu = jnp.mean(y, axis=-1, keepdims=True)
        var = jnp.mean(jnp.square(y - mu), axis=-1, keepdims=True)
        yn = ((y - mu) * lax.rsqrt(var + LNX_EPS)).reshape(y.shape[:2] + (RWKV_DIM,))
        bonus = (dirs[0][4] + dirs[1][4]).reshape(yn.shape)
        return ((yn * lnx_g + lnx_b + bonus) * gate).astype(dtype)

    return finish(ys_l, dirs_l, gate_l, xm_lat.dtype), finish(ys_c, dirs_c, gate_c, xm_ctx.dtype)


def _mixer_rwkv7_gqa(h_lat, h_ctx, w_in, shift_mu, w0_f, w0_b, ww2_f, ww2_b, a0_f, a0_b, wa2_f, wa2_b,
                     wg2, k_k, k_a, r_k, lnx_g, lnx_b, q_norm, k_norm, w_out, need_ctx):
    p_lat = h_lat @ w_in
    p_ctx = h_ctx @ w_in
    qkv_sizes = (GQA_Q_HEADS * HEAD_DIM, GQA_KV_HEADS * HEAD_DIM, GQA_KV_HEADS * HEAD_DIM)
    q_l, k_l, v_l = _split(p_lat[..., :GQA_COLS], qkv_sizes)
    q_c, k_c, v_c = _split(p_ctx[..., :GQA_COLS], qkv_sizes)
    scale = HEAD_DIM ** -0.5
    cos, sin = _axial_rope(h_lat.shape[1])
    q_l = _rope(_rms_norm(_heads(q_l, GQA_Q_HEADS), q_norm), cos, sin) * scale
    k_l = _rope(_rms_norm(_heads(k_l, GQA_KV_HEADS), k_norm), cos, sin)
    q_c = _rms_norm(_heads(q_c, GQA_Q_HEADS), q_norm) * scale
    k_c = _rms_norm(_heads(k_c, GQA_KV_HEADS), k_norm)
    v_l = _heads(v_l, GQA_KV_HEADS)
    v_c = _heads(v_c, GQA_KV_HEADS)
    k_all = jnp.concatenate([k_l, k_c], axis=1)
    v_all = jnp.concatenate([v_l, v_c], axis=1)
    o_gqa_l = _gqa_blocks(q_l, k_all, v_all)

    rw_l = p_lat[..., GQA_COLS:]
    rw_c = p_ctx[..., GQA_COLS:]
    rw_l = rw_l + shift_mu * (_qshift_grid(rw_l) - rw_l)
    rw_c = rw_c + shift_mu * (_shift_seq(rw_c) - rw_c)
    o_rwkv_l, o_rwkv_c = _rwkv7_bidirectional(rw_l, rw_c, w0_f, w0_b, ww2_f, ww2_b, a0_f, a0_b, wa2_f, wa2_b,
                                              wg2, k_k, k_a, r_k, lnx_g, lnx_b)
    out_l = jnp.concatenate([o_gqa_l, o_rwkv_l], axis=-1) @ w_out
    if not need_ctx:
        return out_l, None
    b, n = q_c.shape[:2]
    q_c5 = q_c.reshape(b, n, GQA_KV_HEADS, GQA_Q_HEADS // GQA_KV_HEADS, HEAD_DIM)
    o_gqa_c = _gqa_dense(q_c5, k_c, v_c).reshape(b, n, GQA_Q_HEADS * HEAD_DIM)
    out_c = jnp.concatenate([o_gqa_c, o_rwkv_c], axis=-1) @ w_out
    return out_l, out_c


def _neighbourhood_attention(q, k, v, k_ctx, v_ctx, rpb):
    b, t, h, dh = q.shape
    rows = t // GRID_W
    kr = min(NA_ROWS_MAX, rows)
    kc = NA_COLS
    nk = kr * kc
    q_rows = q.reshape(b, rows, GRID_W, h, dh).transpose(1, 0, 2, 3, 4)
    col = jnp.arange(GRID_W, dtype=jnp.int32)
    col_start = jnp.clip(col - kc // 2, 0, GRID_W - kc)
    key_cols = col_start[:, None] + jnp.arange(kc, dtype=jnp.int32)[None, :]
    dcol = key_cols - col[:, None] + (NA_COLS - 1)

    def row_step(args):
        i, qi = args
        row_start = jnp.clip(i - kr // 2, 0, rows - kr)
        key_rows = row_start + jnp.arange(kr, dtype=jnp.int32)
        idx = (key_rows[None, :, None] * GRID_W + key_cols[:, None, :]).reshape(GRID_W, nk)
        kg = jnp.take(k, idx, axis=1)
        vg = jnp.take(v, idx, axis=1)
        drow = key_rows - i + (NA_ROWS_MAX - 1)
        bias = rpb[:, drow][:, :, dcol]
        bias = bias.transpose(0, 2, 1, 3).reshape(h, GRID_W, nk).astype(jnp.float32)
        s_win = jnp.einsum('bqhd,bqnhd->bhqn', qi, kg).astype(jnp.float32) + bias
        s_ctx = jnp.einsum('bqhd,bchd->bhqc', qi, k_ctx).astype(jnp.float32)
        p = jax.nn.softmax(jnp.concatenate([s_win, s_ctx], axis=-1), axis=-1).astype(v.dtype)
        return (jnp.einsum('bhqn,bqnhd->bqhd', p[..., :nk], vg)
                + jnp.einsum('bhqc,bchd->bqhd', p[..., nk:], v_ctx))

    o = lax.map(row_step, (jnp.arange(rows, dtype=jnp.int32), q_rows))
    return o.transpose(1, 0, 2, 3, 4).reshape(b, t, h * dh)


def _mixer_neighbourhood(h_lat, h_ctx, w_qkv, rpb, w_out, need_ctx):
    width = NA_HEADS * HEAD_DIM
    scale = HEAD_DIM ** -0.5
    q_l, k_l, v_l = [_heads(t, NA_HEADS) for t in _split(h_lat @ w_qkv, (width, width, width))]
    if need_ctx:
        q_c, k_c, v_c = [_heads(t, NA_HEADS) for t in _split(h_ctx @ w_qkv, (width, width, width))]
    else:
        k_c, v_c = [_heads(t, NA_HEADS) for t in _split(h_ctx @ w_qkv[:, width:], (width, width))]
    out_l = _neighbourhood_attention(q_l * scale, k_l, v_l, k_c, v_c, rpb) @ w_out
    if not need_ctx:
        return out_l, None
    b, n = q_c.shape[:2]
    o_c = _gqa_dense((q_c * scale)[:, :, :, None, :], k_c, v_c).reshape(b, n, width)
    return out_l, o_c @ w_out


def setup_inputs(seed: int = 0) -> dict:
    key = jax.random.key(seed)
    keys = jax.random.split(key, 64)
    counter = [0]

    def nxt():
        kk = keys[counter[0]]
        counter[0] += 1
        return kk

    def nrm(shape, scale):
        return jax.random.normal(nxt(), shape, jnp.float32) * scale

    def gain(shape):
        return 1.0 + nrm(shape, 0.1)

    def unif(shape, lo, hi):
        return jax.random.uniform(nxt(), shape, jnp.float32, lo, hi)

    d = D_MODEL
    inp = {}
    inp['x'] = nrm((BATCH, SEQ, d), 1.0)
    inp['c'] = nrm((BATCH, d), 1.0)
    inp['ctx'] = nrm((BATCH, CTX_LEN, d), 1.0)
    inp['c_ctx'] = nrm((d,), 1.0)
    inp['l0_norm1'] = gain((d,))
    inp['l0_norm2'] = gain((d,))
    inp['l0_ada_w'] = nrm((d, 6 * d), 0.5 * d ** -0.5)
    inp['l0_ada_b'] = nrm((6 * d,), 0.01)
    inp['l0_w_in'] = nrm((d, IN_COLS_AB), d ** -0.5)
    inp['l0_shift_mu'] = unif((RWKV_COLS,), 0.0, 1.0)
    inp['l0_w0_f'] = unif((RWKV_DIM,), -4.0, 1.0)
    inp['l0_w0_b'] = unif((RWKV_DIM,), -4.0, 1.0)
    inp['l0_ww2_f'] = nrm((DECAY_LORA, RWKV_DIM), 0.1)
    inp['l0_ww2_b'] = nrm((DECAY_LORA, RWKV_DIM), 0.1)
    inp['l0_a0_f'] = nrm((RWKV_DIM,), 0.1)
    inp['l0_a0_b'] = nrm((RWKV_DIM,), 0.1)
    inp['l0_wa2_f'] = nrm((ICLR_LORA, RWKV_DIM), 0.1)
    inp['l0_wa2_b'] = nrm((ICLR_LORA, RWKV_DIM), 0.1)
    inp['l0_wg2'] = nrm((GATE_LORA, RWKV_DIM), GATE_LORA ** -0.5)
    inp['l0_k_k'] = 0.85 + nrm((RWKV_DIM,), 0.1)
    inp['l0_k_a'] = gain((RWKV_DIM,))
    inp['l0_r_k'] = nrm((RWKV_HEADS, HEAD_DIM), 0.1)
    inp['l0_lnx_g'] = gain((RWKV_DIM,))
    inp['l0_lnx_b'] = nrm((RWKV_DIM,), 0.01)
    inp['l0_q_norm'] = gain((HEAD_DIM,))
    inp['l0_k_norm'] = gain((HEAD_DIM,))
    inp['l0_w_out'] = nrm((OUT_COLS_AB, d), OUT_COLS_AB ** -0.5)
    inp['l0_mlp_w1'] = nrm((d, D_FF), d ** -0.5)
    inp['l0_mlp_w2'] = nrm((D_FF, d), D_FF ** -0.5)
    inp['l1_norm1'] = gain((d,))
    inp['l1_norm2'] = gain((d,))
    inp['l1_ada_w'] = nrm((d, 6 * d), 0.5 * d ** -0.5)
    inp['l1_ada_b'] = nrm((6 * d,), 0.01)
    inp['l1_w_qkv'] = nrm((d, 3 * NA_HEADS * HEAD_DIM), d ** -0.5)
    inp['l1_rpb'] = nrm((NA_HEADS, 2 * NA_ROWS_MAX - 1, 2 * NA_COLS - 1), 0.02)
    inp['l1_w_out'] = nrm((NA_HEADS * HEAD_DIM, d), (NA_HEADS * HEAD_DIM) ** -0.5)
    inp['l1_mlp_w1'] = nrm((d, D_FF), d ** -0.5)
    inp['l1_mlp_w2'] = nrm((D_FF, d), D_FF ** -0.5)
    inp['final_norm'] = gain((d,))
    return inp


def reference(x, c, ctx, c_ctx,
              l0_norm1, l0_norm2, l0_ada_w, l0_ada_b, l0_w_in, l0_shift_mu,
              l0_w0_f, l0_w0_b, l0_ww2_f, l0_ww2_b, l0_a0_f, l0_a0_b, l0_wa2_f, l0_wa2_b,
              l0_wg2, l0_k_k, l0_k_a, l0_r_k, l0_lnx_g, l0_lnx_b, l0_q_norm, l0_k_norm,
              l0_w_out, l0_mlp_w1, l0_mlp_w2,
              l1_norm1, l1_norm2, l1_ada_w, l1_ada_b, l1_w_qkv, l1_rpb, l1_w_out,
              l1_mlp_w1, l1_mlp_w2, final_norm):
    norm1 = (l0_norm1, l1_norm1)
    norm2 = (l0_norm2, l1_norm2)
    ada_w = (l0_ada_w, l1_ada_w)
    ada_b = (l0_ada_b, l1_ada_b)
    mlp_w1 = (l0_mlp_w1, l1_mlp_w1)
    mlp_w2 = (l0_mlp_w2, l1_mlp_w2)
    for layer in range(DEPTH):
        last = layer == DEPTH - 1
        mod = jax.nn.silu(c) @ ada_w[layer] + ada_b[layer]
        mod_c = jax.nn.silu(c_ctx) @ ada_w[layer] + ada_b[layer]
        sh1, sc1, g1, sh2, sc2, g2 = jnp.split(mod[:, None, :], 6, axis=-1)
        csh1, csc1, cg1, csh2, csc2, cg2 = jnp.split(mod_c, 6, axis=-1)
        h = _modulate(_rms_norm(x, norm1[layer]), sh1, sc1)
        hc = _modulate(_rms_norm(ctx, norm1[layer]), csh1, csc1)
        if layer % 2 == 0:
            o, oc = _mixer_rwkv7_gqa(h, hc, l0_w_in, l0_shift_mu, l0_w0_f, l0_w0_b, l0_ww2_f, l0_ww2_b,
                                     l0_a0_f, l0_a0_b, l0_wa2_f, l0_wa2_b, l0_wg2, l0_k_k, l0_k_a, l0_r_k,
                                     l0_lnx_g, l0_lnx_b, l0_q_norm, l0_k_norm, l0_w_out, not last)
        else:
            o, oc = _mixer_neighbourhood(h, hc, l1_w_qkv, l1_rpb, l1_w_out, not last)
        x = x + g1 * o
        x = x + g2 * _sq_relu_mlp(_modulate(_rms_norm(x, norm2[layer]), sh2, sc2), mlp_w1[layer], mlp_w2[layer])
        if not last:
            ctx = ctx + cg1 * oc
            ctx = ctx + cg2 * _sq_relu_mlp(_modulate(_rms_norm(ctx, norm2[layer]), csh2, csc2),
                                           mlp_w1[layer], mlp_w2[layer])
    return _rms_norm(x, final_norm)
```

```cpp
#include <hip/hip_runtime.h>
#include <hip/hip_bf16.h>
#include <hip/hip_cooperative_groups.h>
#include <cstdio>
#include <cstdint>
#include <cmath>
namespace cg = cooperative_groups;
namespace pg8 {
#define PG8_LAS __attribute__((address_space(3)))
typedef unsigned short bf16_t;
typedef short bf16x8 __attribute__((ext_vector_type(8)));
typedef float f32x4 __attribute__((ext_vector_type(4)));
typedef unsigned u32x4 __attribute__((ext_vector_type(4)));
constexpr int BM = 256, BK = 64, HALF = 128, HTB = HALF * BK * 2  , STAGE_BYTES = 8 * HTB, NXCD = 8, WGM = 8;

__host__ __device__ __forceinline__ int lds_byte(int r, int c) { const int st = (r >> 4) * 2 + (c >> 5), rr = r & 15, cc = c & 31, ob = rr * 64 + cc * 2; return st * 1024 + (ob ^ (((ob >> 9) & 1) << 5)); }
__host__ __device__ __forceinline__ void stage_rc(int b, int& R, int& C) { const int st = b / 1024, sb = b % 1024, swz = sb ^ (((sb >> 9) & 1) << 5); R = (st >> 1) * 16 + swz / 64; C = (st & 1) * 32 + (swz % 64) / 2; }
__host__ __device__ __forceinline__ int perm32(int rho) { const int n = rho >> 4, i = rho & 15; return 8 * (i >> 2) + 4 * n + (i & 3); }

struct Unit { int pm, pn, ks; };
struct Gemm { const bf16_t* A; const bf16_t* Bt; int M, N, K, Kc; };

struct StaticOrder {
    int nM, nN, nwg, G, c;
    __host__ __device__ void init(int M, int N, int G_, int c_) { nM = M / BM; nN = N / BM; nwg = nM * nN; G = G_; c = c_; }
    __host__ __device__ bool next(int i, Unit& u) const {
        const long L = (long)i * G + c; if (L >= nwg) return false;
        int wgid = (int)L; { const int q = nwg / NXCD, r = nwg % NXCD, xcd = wgid % NXCD, off = wgid / NXCD; wgid = (xcd < r ? xcd * (q + 1) : r * (q + 1) + (xcd - r) * q) + off; }
        const int nig = WGM * nN, gid = wgid / nig, fm = gid * WGM, gsz = (nM - fm) < WGM ? (nM - fm) : WGM;
        u.pm = fm + ((wgid % nig) % gsz); u.pn = (wgid % nig) / gsz; u.ks = 0; return true;
    }
    __device__ __forceinline__ void a_ready(const Unit&) const {}
    __device__ __forceinline__ void done(const Unit&) const {}
};

struct SplitOrder {
    int nM, nN, ksplit, total, G, c;
    __host__ __device__ void init(int M, int N, int ksplit_, int G_, int c_) { nM = M / BM; nN = N / BM; ksplit = ksplit_; total = nM * nN * ksplit; G = G_; c = c_; }
    __host__ __device__ bool next(int i, Unit& u) const { const long L = (long)i * G + c; if (L >= total) return false; const int t = (int)(L / ksplit); u.ks = (int)(L % ksplit); u.pn = t % nN; u.pm = t / nN; return true; }
    __device__ __forceinline__ void a_ready(const Unit&) const {}
    __device__ __forceinline__ void done(const Unit&) const {}
};
struct SliceOrder : StaticOrder {
    int pn1;
    __host__ __device__ bool next(int i, Unit& u) const { if (!StaticOrder::next(i, u)) return false; u.ks = u.pn >= pn1 ? 1 : 0; return true; }
};
__device__ __forceinline__ unsigned cvt_pk_bf16(float lo, float hi) { unsigned r; asm volatile("v_cvt_pk_bf16_f32 %0, %1, %2" : "=v"(r) : "v"(lo), "v"(hi)); return r; }
typedef float f32x2 __attribute__((ext_vector_type(2)));
template <int ACT> struct EpiBf16 {
    static constexpr bool PERM = true, AFTER_DRAIN = false;
    bf16_t* O; int ldc; int split_cols; size_t split_stride; float scale0; const float* zb;
    __device__ __forceinline__ void operator()(const f32x4 (&acc)[2][2][4][2], const Unit& u, int wr, int wc, int fr, int fq) const {
        const int row0 = u.pm * BM + wr * 64 + fr; int colt = u.pn * BM; bf16_t* base = O;
        float sc = 1.f; if (split_cols) { const int t = colt / split_cols; base += (size_t)t * split_stride; colt -= t * split_cols; if (t == 0) sc = scale0; }
        const int col0 = colt + wc * 32 + 8 * fq;
        int blk = 0; int cb = 0;
        if (ACT == 3) { blk = u.pn >> 2; cb = u.pn * BM + wc * 32 + 8 * fq; }
#pragma unroll
        for (int ai = 0; ai < 2; ++ai)
#pragma unroll
            for (int m = 0; m < 4; ++m) { bf16_t* rowp = base + (size_t)(row0 + ai * HALF + m * 16) * ldc + col0;
#pragma unroll
                for (int bj = 0; bj < 2; ++bj) { f32x4 v0 = acc[ai][bj][m][0], v1 = acc[ai][bj][m][1];
                    if (ACT == 2) {
#pragma unroll
                        for (int e = 0; e < 4; ++e) { float a = fmaxf(v0[e], 0.f), b = fmaxf(v1[e], 0.f); v0[e] = a * a; v1[e] = b * b; } }
                    if (ACT == 3) {
                        v0 = v0 + *(const f32x4*)(zb + cb + bj * HALF); v1 = v1 + *(const f32x4*)(zb + cb + bj * HALF + 4);
                        if (blk < 4) {
#pragma unroll
                            for (int e = 0; e < 4; ++e) { float s0 = 1.f / (1.f + __expf(-v0[e])), s1 = 1.f / (1.f + __expf(-v1[e]));
                                if (blk < 2) { s0 = 1.f - __expf(-0.60653066f * s0); s1 = 1.f - __expf(-0.60653066f * s1); }
                                v0[e] = s0; v1[e] = s1; } } }
                    v0 = v0 * sc; v1 = v1 * sc; u32x4 w; w.x = cvt_pk_bf16(v0[0], v0[1]); w.y = cvt_pk_bf16(v0[2], v0[3]); w.z = cvt_pk_bf16(v1[0], v1[1]); w.w = cvt_pk_bf16(v1[2], v1[3]);
                    *(u32x4*)(rowp + bj * HALF) = w; } }
    }
};
struct EpiResid {
    static constexpr bool PERM = false, AFTER_DRAIN = false;
    const float* baseL; const float* baseC; float* outL; float* outC; const float* gate;
    __device__ __forceinline__ void operator()(const f32x4 (&acc)[2][2][4][2], const Unit& u, int wr, int wc, int fr, int fq) const {
        const int trow = u.pm * BM; const bool isc = trow >= 16384; const int ridx = isc ? 4 : (trow >> 12);
        const float* g = gate + (size_t)ridx * 12288; const float* base = isc ? baseC : baseL; float* out = isc ? outC : outL;
        const int row0 = (isc ? trow - 16384 : trow) + wr * 64 + fr; const int col0 = u.pn * BM + wc * 32 + 4 * fq;
#pragma unroll
        for (int bj = 0; bj < 2; ++bj)
#pragma unroll
            for (int n = 0; n < 2; ++n) { const f32x4 gv = *(const f32x4*)(g + col0 + bj * HALF + n * 16);
#pragma unroll
                for (int ai = 0; ai < 2; ++ai)
#pragma unroll
                    for (int m = 0; m < 4; ++m) { const size_t off = (size_t)(row0 + ai * HALF + m * 16) * 2048 + col0 + bj * HALF + n * 16;
                        const f32x4 bs = *(const f32x4*)(base + off); *(f32x4*)(out + off) = bs + gv * acc[ai][bj][m][n]; } }
    }
};
struct EpiPartial {
    static constexpr bool PERM = true, AFTER_DRAIN = false;
    float* part;
    __device__ __forceinline__ void operator()(const f32x4 (&acc)[2][2][4][2], const Unit& u, int wr, int wc, int fr, int fq) const {
        float* out = part + (size_t)u.ks * (1024 * 2048); const int row0 = u.pm * BM + wr * 64 + fr; const int col0 = u.pn * BM + wc * 32 + 8 * fq;
#pragma unroll
        for (int bj = 0; bj < 2; ++bj)
#pragma unroll
            for (int ai = 0; ai < 2; ++ai)
#pragma unroll
                for (int m = 0; m < 4; ++m) { float* o = out + (size_t)(row0 + ai * HALF + m * 16) * 2048 + col0 + bj * HALF; *(f32x4*)(o) = acc[ai][bj][m][0]; *(f32x4*)(o + 4) = acc[ai][bj][m][1]; }
    }
};
template <bool BASE_BF16> struct EpiResidB {
    static constexpr bool PERM = true, AFTER_DRAIN = false;
    const float* baseLf; const bf16_t* baseLb; const float* baseC; bf16_t* outLb; float* outC; const float* gate;
    __device__ __forceinline__ void operator()(const f32x4 (&acc)[2][2][4][2], const Unit& u, int wr, int wc, int fr, int fq) const {
        const int trow = u.pm * BM; const bool isc = trow >= 16384; const int ridx = isc ? 4 : (trow >> 12);
        const float* g = gate + (size_t)ridx * 12288; const int row0 = (isc ? trow - 16384 : trow) + wr * 64 + fr; const int col0 = u.pn * BM + wc * 32 + 8 * fq;
#pragma unroll
        for (int bj = 0; bj < 2; ++bj) { const f32x4 g0 = *(const f32x4*)(g + col0 + bj * HALF), g1 = *(const f32x4*)(g + col0 + bj * HALF + 4);
#pragma unroll
            for (int ai = 0; ai < 2; ++ai)
#pragma unroll
                for (int m = 0; m < 4; ++m) { const size_t off = (size_t)(row0 + ai * HALF + m * 16) * 2048 + col0 + bj * HALF;
                    if (isc) { *(f32x4*)(outC + off) = *(const f32x4*)(baseC + off) + g0 * acc[ai][bj][m][0]; *(f32x4*)(outC + off + 4) = *(const f32x4*)(baseC + off + 4) + g1 * acc[ai][bj][m][1]; }
                    else { f32x4 b0, b1;
                        if (BASE_BF16) { const u32x4 w = *(const u32x4*)(baseLb + off);
                            b0 = (f32x4){__uint_as_float(w.x << 16), __uint_as_float(w.x & 0xffff0000u), __uint_as_float(w.y << 16), __uint_as_float(w.y & 0xffff0000u)};
                            b1 = (f32x4){__uint_as_float(w.z << 16), __uint_as_float(w.z & 0xffff0000u), __uint_as_float(w.w << 16), __uint_as_float(w.w & 0xffff0000u)}; }
                        else { b0 = __builtin_nontemporal_load((const f32x4*)(baseLf + off)); b1 = __builtin_nontemporal_load((const f32x4*)(baseLf + off + 4)); }
                        const f32x4 o0 = b0 + g0 * acc[ai][bj][m][0], o1 = b1 + g1 * acc[ai][bj][m][1];
                        u32x4 w; w.x = cvt_pk_bf16(o0[0], o0[1]); w.y = cvt_pk_bf16(o0[2], o0[3]); w.z = cvt_pk_bf16(o1[0], o1[1]); w.w = cvt_pk_bf16(o1[2], o1[3]);
                        *(u32x4*)(outLb + off) = w; } } }
    }
};
template <class Epi, class Sched, bool ALIGN_EPI = false, bool SP2 = false>
__device__ __forceinline__ void gemm_phase(PG8_LAS unsigned char* lds, const Gemm g, const Sched& S, const Epi& E) {
    int tid_ = threadIdx.x; asm volatile("" : "+v"(tid_)); const int tid = tid_, wid = __builtin_amdgcn_readfirstlane(tid >> 6), lane = tid & 63, wr = wid >> 2, wc = wid & 3, fr = lane & 15, fq = lane >> 4;
    const int K = g.K, nt = g.Kc / BK; const size_t kcb = (size_t)g.Kc * 2;
    unsigned voffA[2], voffB[2];
#pragma unroll
    for (int i = 0; i < 2; ++i) { int R, C; stage_rc(tid * 16 + i * 8192, R, C); const int Rb = Epi::PERM ? ((R & ~31) + perm32(R & 31)) : R;
        voffA[i] = (unsigned)(R * K + C) * 2u; voffB[i] = (unsigned)(Rb * K + C) * 2u; }
    const size_t kstep = (size_t)(BK * 2);
    const size_t hstep = (size_t)HALF * K * 2;
    const size_t tstep = 2 * hstep;
    const unsigned ldsw = (unsigned)wid * 1024u;
    const int aoff = lds_byte(wr * 64 + fr, fq * 8), boff = lds_byte(wc * 32 + fr, fq * 8);
#define PG8_SA(b, h) (((b) * 2 + (h)) * HTB)
#define PG8_SB(b, h) ((4 + (b) * 2 + (h)) * HTB)
#define PG8_STAGE(bufoff, gbase, voff) do { _Pragma("unroll") for (int _i = 0; _i < 2; ++_i) \
        __builtin_amdgcn_global_load_lds((const unsigned*)((const char*)(gbase) + (voff)[_i]), (PG8_LAS unsigned*)(lds + (bufoff) + ldsw + _i * 8192), 16, 0, 0); } while (0)
#define PG8_LDA(dst, b, h) do { _Pragma("unroll") for (int m = 0; m < 4; ++m) _Pragma("unroll") for (int k = 0; k < 2; ++k) dst[m][k] = *(const PG8_LAS bf16x8*)(lds + PG8_SA(b, h) + aoff + m * 2048 + k * 1024); } while (0)
#define PG8_LDB(dst, b, h) do { _Pragma("unroll") for (int n = 0; n < 2; ++n) _Pragma("unroll") for (int k = 0; k < 2; ++k) dst[n][k] = *(const PG8_LAS bf16x8*)(lds + PG8_SB(b, h) + boff + n * 2048 + k * 1024); } while (0)
#define PG8_MMA(ai, bj, At, Bt) do { __builtin_amdgcn_s_setprio(1); _Pragma("unroll") for (int m = 0; m < 4; ++m) _Pragma("unroll") for (int n = 0; n < 2; ++n) _Pragma("unroll") for (int k = 0; k < 2; ++k) \
        acc[ai][bj][m][n] = __builtin_amdgcn_mfma_f32_16x16x32_bf16(Bt[n][k], At[m][k], acc[ai][bj][m][n], 0, 0, 0); __builtin_amdgcn_s_setprio(0); } while (0)
#define PG8_WAIT_V(n) asm volatile("s_waitcnt vmcnt(" #n ")" ::: "memory")
#define PG8_WAIT_L(n) asm volatile("s_waitcnt lgkmcnt(" #n ")" ::: "memory")
#define PG8_BAR __builtin_amdgcn_s_barrier()
#define PG8_SCHED __builtin_amdgcn_sched_barrier(0)
    Unit cur, nxt; int ui = 0;
    if (!S.next(0, cur)) return;
    f32x4 acc[2][2][4][2];
#pragma unroll
    for (int a = 0; a < 2; ++a)
#pragma unroll
        for (int b = 0; b < 2; ++b)
#pragma unroll
            for (int m = 0; m < 4; ++m)
#pragma unroll
                for (int n = 0; n < 2; ++n) acc[a][b][m][n] = (f32x4){0.f, 0.f, 0.f, 0.f};
    bf16x8 At[4][2], B0[2][2], B1[2][2];
    const char* cA = (const char*)g.A + (size_t)cur.pm * tstep + (size_t)cur.ks * kcb; const char* cB = (const char*)g.Bt + (size_t)cur.pn * tstep + (size_t)cur.ks * kcb;
    S.a_ready(cur);
    if constexpr (SP2) {
        PG8_STAGE(PG8_SB(0, 0), cB, voffB); PG8_STAGE(PG8_SB(0, 1), cB + hstep, voffB); PG8_STAGE(PG8_SA(0, 0), cA, voffA); PG8_STAGE(PG8_SA(0, 1), cA + hstep, voffA);
        if (wr == 1) PG8_BAR;
        PG8_WAIT_V(2); PG8_BAR;
        PG8_STAGE(PG8_SB(1, 0), cB + kstep, voffB); PG8_STAGE(PG8_SA(1, 0), cA + kstep, voffA); PG8_STAGE(PG8_SB(1, 1), cB + hstep + kstep, voffB);
        PG8_WAIT_V(6); PG8_BAR;
    } else {
        PG8_STAGE(PG8_SB(0, 0), cB, voffB); PG8_STAGE(PG8_SA(0, 0), cA, voffA); PG8_STAGE(PG8_SB(0, 1), cB + hstep, voffB); PG8_STAGE(PG8_SA(0, 1), cA + hstep, voffA);
        if (wr == 1) PG8_BAR;
        PG8_WAIT_V(4); PG8_BAR;
        PG8_STAGE(PG8_SB(1, 0), cB + kstep, voffB); PG8_STAGE(PG8_SA(1, 0), cA + kstep, voffA); PG8_STAGE(PG8_SB(1, 1), cB + hstep + kstep, voffB);
        PG8_WAIT_V(6); PG8_BAR;
    }
    for (;;) {
        const bool has_next = S.next(ui + 1, nxt);
        const char* nA = has_next ? (const char*)g.A + (size_t)nxt.pm * tstep + (size_t)nxt.ks * kcb : cA; const char* nB = has_next ? (const char*)g.Bt + (size_t)nxt.pn * tstep + (size_t)nxt.ks * kcb : cB;
        for (int t = 0; t < nt; t += 2) {
            const bool last = (t == nt - 2);
            const char* a1 = cA + (size_t)(t + 1) * kstep;
            const char* a2 = last ? nA : cA + (size_t)(t + 2) * kstep; const char* b2 = last ? nB : cB + (size_t)(t + 2) * kstep;
            const char* a3 = a2 + kstep; const char* b3 = b2 + kstep;
            if (last && has_next) S.a_ready(nxt);
            if constexpr (SP2) {
            PG8_LDB(B0, 0, 0); PG8_LDB(B1, 0, 1); PG8_SCHED; PG8_LDA(At, 0, 0); PG8_STAGE(PG8_SA(1, 1), a1 + hstep, voffA);
            PG8_WAIT_V(8); PG8_WAIT_L(0); PG8_BAR; PG8_MMA(0, 0, At, B0); PG8_MMA(0, 1, At, B1); PG8_BAR; PG8_SCHED;
            PG8_LDA(At, 0, 1); PG8_STAGE(PG8_SB(0, 0), b2, voffB); PG8_STAGE(PG8_SB(0, 1), b2 + hstep, voffB); PG8_STAGE(PG8_SA(0, 0), a2, voffA);
            PG8_WAIT_V(8); PG8_WAIT_L(0); PG8_BAR; PG8_MMA(1, 0, At, B0); PG8_MMA(1, 1, At, B1); PG8_BAR; PG8_SCHED;
            PG8_LDB(B0, 1, 0); PG8_LDB(B1, 1, 1); PG8_SCHED; PG8_LDA(At, 1, 0); PG8_STAGE(PG8_SA(0, 1), a2 + hstep, voffA);
            PG8_WAIT_V(8); PG8_WAIT_L(0); PG8_BAR; PG8_MMA(0, 0, At, B0); PG8_MMA(0, 1, At, B1); PG8_BAR; PG8_SCHED;
            PG8_LDA(At, 1, 1); PG8_STAGE(PG8_SB(1, 0), b3, voffB); PG8_STAGE(PG8_SB(1, 1), b3 + hstep, voffB); PG8_STAGE(PG8_SA(1, 0), a3, voffA);
            PG8_WAIT_V(8); PG8_WAIT_L(0); PG8_BAR; PG8_MMA(1, 0, At, B0); PG8_MMA(1, 1, At, B1); PG8_BAR; PG8_SCHED;
            } else {
            PG8_LDB(B0, 0, 0); PG8_SCHED; PG8_LDA(At, 0, 0); PG8_STAGE(PG8_SA(1, 1), a1 + hstep, voffA);
            PG8_WAIT_L(8); PG8_BAR; PG8_WAIT_L(0); PG8_MMA(0, 0, At, B0); PG8_BAR; PG8_SCHED;
            PG8_LDB(B1, 0, 1); PG8_STAGE(PG8_SB(0, 0), b2, voffB);
            PG8_BAR; PG8_WAIT_L(0); PG8_MMA(0, 1, At, B1); PG8_BAR;
            PG8_LDA(At, 0, 1); PG8_STAGE(PG8_SA(0, 0), a2, voffA);
            PG8_BAR; PG8_WAIT_L(0); PG8_MMA(1, 0, At, B0); PG8_BAR; PG8_SCHED;
            PG8_STAGE(PG8_SB(0, 1), b2 + hstep, voffB);
            PG8_WAIT_V(6); PG8_BAR; PG8_MMA(1, 1, At, B1); PG8_BAR;
            PG8_LDB(B0, 1, 0); PG8_SCHED; PG8_LDA(At, 1, 0); PG8_STAGE(PG8_SA(0, 1), a2 + hstep, voffA);
            PG8_WAIT_L(8); PG8_BAR; PG8_WAIT_L(0); PG8_MMA(0, 0, At, B0); PG8_BAR; PG8_SCHED;
            PG8_LDB(B1, 1, 1); PG8_STAGE(PG8_SB(1, 0), b3, voffB);
            PG8_BAR; PG8_WAIT_L(0); PG8_MMA(0, 1, At, B1); PG8_BAR;
            PG8_LDA(At, 1, 1); PG8_STAGE(PG8_SA(1, 0), a3, voffA);
            PG8_BAR; PG8_WAIT_L(0); PG8_MMA(1, 0, At, B0); PG8_BAR; PG8_SCHED;
            PG8_STAGE(PG8_SB(1, 1), b3 + hstep, voffB);
            PG8_WAIT_V(6); PG8_BAR; PG8_MMA(1, 1, At, B1); PG8_BAR;
            }
        }
        if constexpr (ALIGN_EPI) { if (wr == 0) PG8_BAR; }
        if constexpr (!Epi::AFTER_DRAIN) { E(acc, cur, wr, wc, fr, fq); S.done(cur); }
        if (!has_next) break;
#pragma unroll
        for (int a = 0; a < 2; ++a)
#pragma unroll
            for (int b = 0; b < 2; ++b)
#pragma unroll
                for (int m = 0; m < 4; ++m)
#pragma unroll
                    for (int n = 0; n < 2; ++n) acc[a][b][m][n] = (f32x4){0.f, 0.f, 0.f, 0.f};
        cur = nxt; cA = nA; cB = nB; ++ui;
        if constexpr (ALIGN_EPI) { if (wr == 1) PG8_BAR; }
    }
    PG8_WAIT_V(0);
    if constexpr (!ALIGN_EPI) { if (wr == 0) PG8_BAR; }
    PG8_BAR;
    if constexpr (Epi::AFTER_DRAIN) { E.fused(acc, cur, wr, wc, fr, fq, lds, wid, lane); S.done(cur); }
#undef PG8_SA
#undef PG8_SB
#undef PG8_STAGE
#undef PG8_LDA
#undef PG8_LDB
#undef PG8_MMA
#undef PG8_WAIT_V
#undef PG8_WAIT_L
#undef PG8_BAR
#undef PG8_SCHED
}
}
__device__ __forceinline__ int tidx() { int t = threadIdx.x; asm volatile("" : "+v"(t)); return t; }
namespace att {
constexpr int NW=8,QBLK=32,KVBLK=64;
using bf16=__hip_bfloat16;
using bf16x8=__attribute__((ext_vector_type(8)))short;
using s16x4=__attribute__((ext_vector_type(4)))short;
using f32x16=__attribute__((ext_vector_type(16)))float;
using u32x4=__attribute__((ext_vector_type(4)))unsigned;
__device__ __forceinline__ int crow(int r,int hi){return (r&3)+8*(r>>2)+4*hi;}
#define SBAR() __builtin_amdgcn_sched_barrier(0)
__device__ __forceinline__ float max3f(float a,float b,float c){float r;asm("v_max3_f32 %0, %1, %2, %3":"=v"(r):"v"(a),"v"(b),"v"(c));return r;}
__device__ __forceinline__ float max2f(float a,float b){float r;asm("v_max_f32_e32 %0, %1, %2":"=v"(r):"v"(a),"v"(b));return r;}
__device__ __forceinline__ float fadd_s(float a,float b){float r;asm("v_add_f32_e32 %0, %1, %2":"=v"(r):"v"(a),"v"(b));return r;}
__device__ __forceinline__ float fsub_s(float a,float b){float r;asm("v_sub_f32_e32 %0, %1, %2":"=v"(r):"v"(a),"v"(b));return r;}
typedef float f32x2_t __attribute__((ext_vector_type(2))); typedef __bf16 bf16x2_t __attribute__((ext_vector_type(2)));
__device__ __forceinline__ unsigned cvtpk_s(float lo,float hi){f32x2_t v={lo,hi};bf16x2_t b=__builtin_convertvector(v,bf16x2_t);return __builtin_bit_cast(unsigned,b);}
__device__ __forceinline__ void qkt(f32x16&p0,f32x16&p1,const char*Kslot,const bf16x8*qr,const f32x16&negm,int r32,int hi){
  const char*kb=Kslot+hi*1024+r32*16;
  #pragma unroll
  for(int d0=0;d0<4;++d0){
    const bf16x8 b0=*reinterpret_cast<const bf16x8*>(kb+d0*2048);
    const bf16x8 b1=*reinterpret_cast<const bf16x8*>(kb+d0*2048+512);
    if(d0==0){p0=__builtin_amdgcn_mfma_f32_32x32x16_bf16(b0,qr[0],negm,0,0,0);p1=__builtin_amdgcn_mfma_f32_32x32x16_bf16(b1,qr[0],negm,0,0,0);}
    else{p0=__builtin_amdgcn_mfma_f32_32x32x16_bf16(b0,qr[d0],p0,0,0,0);p1=__builtin_amdgcn_mfma_f32_32x32x16_bf16(b1,qr[d0],p1,0,0,0);}}
}
__device__ __forceinline__ float rowmax(const f32x16&p0,const f32x16&p1){
  float a=max3f(p0[0],p0[1],p1[0]),b=max3f(p0[2],p0[3],p1[1]);a=max3f(a,p1[2],p1[3]);
  #pragma unroll
  for(int r=4;r<16;r+=4){a=max3f(a,p0[r],p0[r+1]);b=max3f(b,p0[r+2],p0[r+3]);a=max3f(a,p1[r],p1[r+1]);b=max3f(b,p1[r+2],p1[r+3]);}
  const float m=max2f(a,b);
  auto rr=__builtin_amdgcn_permlane32_swap(__float_as_uint(m),__float_as_uint(m),false,false);
  return max2f(__uint_as_float(rr[0]),__uint_as_float(rr[1]));
}
__device__ __forceinline__ void pv(f32x16*o,int vb,bf16x8 pa0,bf16x8 pa1,bf16x8 pa2,bf16x8 pa3){
  #pragma unroll
  for(int d0=0;d0<2;++d0){s16x4 lo[4],hi[4];
    #pragma unroll
    for(int ks=0;ks<4;++ks){
      asm volatile("ds_read_b64_tr_b16 %0,%1 offset:%c2":"=&v"(lo[ks]):"v"(vb),"i"(d0*4096+ks*1024):"memory");
      asm volatile("ds_read_b64_tr_b16 %0,%1 offset:%c2":"=&v"(hi[ks]):"v"(vb),"i"(d0*4096+ks*1024+512):"memory");}
    asm volatile("s_waitcnt lgkmcnt(0)":::"memory");SBAR();
    #define PK(k) (bf16x8){lo[k][0],lo[k][1],lo[k][2],lo[k][3],hi[k][0],hi[k][1],hi[k][2],hi[k][3]}
    o[d0]=__builtin_amdgcn_mfma_f32_32x32x16_bf16(pa0,PK(0),o[d0],0,0,0);
    o[d0]=__builtin_amdgcn_mfma_f32_32x32x16_bf16(pa1,PK(1),o[d0],0,0,0);
    o[d0]=__builtin_amdgcn_mfma_f32_32x32x16_bf16(pa2,PK(2),o[d0],0,0,0);
    o[d0]=__builtin_amdgcn_mfma_f32_32x32x16_bf16(pa3,PK(3),o[d0],0,0,0);
    #undef PK
  }
}
constexpr int NSLOT=3, SLOTB=8192;
constexpr int LDS_K=0, LDS_V=NSLOT*SLOTB, LDS_WS=2*NSLOT*SLOTB, LDS_OST=LDS_WS+NW*64*4, LDS_BYTES=LDS_OST+NW*4096;
constexpr float C2=0.125f*1.4426950408889634f;
__device__ __forceinline__ void glds16(const void*gsrc,unsigned lds_dst){unsigned keep;
  asm volatile("s_mov_b32 %0, m0\n\ts_mov_b32 m0, %2\n\ts_nop 0\n\tglobal_load_lds_dwordx4 %1, off\n\ts_mov_b32 m0, %0":"=&s"(keep):"v"(gsrc),"s"(lds_dst):"memory");}
#define WAIT_BAR(N) asm volatile("s_waitcnt vmcnt(" #N ") lgkmcnt(0)\n\ts_barrier":::"memory")
typedef __attribute__((address_space(3))) const char* lds_cptr;
typedef short v4i16_t __attribute__((ext_vector_type(4)));
__device__ __forceinline__ void kload8(bf16x8*kf,lds_cptr kp){
  kf[0]=*(const __attribute__((address_space(3))) bf16x8*)(kp);      kf[1]=*(const __attribute__((address_space(3))) bf16x8*)(kp+512);
  kf[2]=*(const __attribute__((address_space(3))) bf16x8*)(kp+2048); kf[3]=*(const __attribute__((address_space(3))) bf16x8*)(kp+2560);
  kf[4]=*(const __attribute__((address_space(3))) bf16x8*)(kp+4096); kf[5]=*(const __attribute__((address_space(3))) bf16x8*)(kp+4608);
  kf[6]=*(const __attribute__((address_space(3))) bf16x8*)(kp+6144); kf[7]=*(const __attribute__((address_space(3))) bf16x8*)(kp+6656);
}
__device__ __forceinline__ void kload2(bf16x8*kf,lds_cptr kp,int j){ kf[2*j]=*(const __attribute__((address_space(3))) bf16x8*)(kp+j*2048); kf[2*j+1]=*(const __attribute__((address_space(3))) bf16x8*)(kp+j*2048+512); }
__device__ __forceinline__ s16x4 vtr(lds_cptr p){ return __builtin_bit_cast(s16x4,__builtin_amdgcn_ds_read_tr16_b64_v4i16((__attribute__((address_space(3))) v4i16_t*)p)); }
#ifndef ATTN_STORE16
#define ATTN_STORE16(p,v) (*(u32x4*)(p)=(v))
#endif
template<int THRL> __device__ __forceinline__ void attn_unit_p(const bf16*Qu,int QP,const bf16*__restrict__ Kh,const bf16*__restrict__ Vh,int KP,int NT,bf16*Ou,int OP,char*shm){
  const int tid=tidx(),lane=tid&63,r32=lane&31,hi=lane>>5; const int wid=__builtin_amdgcn_readfirstlane(tid>>6);
  const bf16*Qw=Qu+(long)(wid*QBLK)*QP;
  const unsigned lds0=(unsigned)(uintptr_t)shm;
  float*wsf=(float*)(shm+LDS_WS)+wid*64;
  const bf16*ksrc=Kh+(long)lane*KP+wid*8;
  const bf16*vsrc=Vh+(long)(16*(wid&3)+(lane>>2))*KP+(wid>>2)*32+(lane&3)*8;
  const unsigned kdst=lds0+LDS_K+wid*1024, vdst=lds0+LDS_V+wid*1024;
  #define DMA_K(t,slot) glds16(ksrc+(long)(t)*KVBLK*KP,(unsigned)__builtin_amdgcn_readfirstlane(kdst+(slot)))
  #define DMA_V(t,slot) glds16(vsrc+(long)(t)*KVBLK*KP,(unsigned)__builtin_amdgcn_readfirstlane(vdst+(slot)))
  const int vb0=(int)(lds0+LDS_V)+((lane>>4)&1)*32+(lane&3)*8+(4*hi+((lane&15)>>2))*64;
  const char*Kbase=shm+LDS_K; bf16x8 kf[8];
  const lds_cptr shm3=(lds_cptr)shm; const lds_cptr kp0=shm3+LDS_K+hi*1024+r32*16; const lds_cptr vp0=shm3+LDS_V+((lane>>4)&1)*32+(lane&3)*8+(4*hi+((lane&15)>>2))*64;
  DMA_K(0,0);DMA_V(0,0);DMA_K(1,SLOTB);
  bf16x8 qr[4];
  #pragma unroll
  for(int d0=0;d0<4;++d0)qr[d0]=*reinterpret_cast<const bf16x8*>(&Qw[(long)r32*QP+d0*16+hi*8]);
  float mhat=0.f,l_reg=0.f;f32x16 o[2];o[0]=f32x16{};o[1]=f32x16{};f32x16 negm=f32x16{};asm volatile("":"+v"(negm));
  const int qrel=wid*QBLK+r32;
  #define CMASK(P0,P1,t) do{}while(0)
  bool resc=false;
  #define START(P0,P1) do{ const float rm=rowmax(P0,P1); resc=false; \
    { const float dl=rm; mhat=fadd_s(mhat,dl); \
      _Pragma("unroll") for(int r=0;r<16;++r){P0[r]=fsub_s(P0[r],dl);P1[r]=fsub_s(P1[r],dl);} \
      _Pragma("unroll") for(int r=0;r<16;++r)negm[r]=-mhat; asm volatile("":"+v"(negm)); } \
    _Pragma("unroll") for(int r=0;r<16;++r)P0[r]=__builtin_amdgcn_exp2f(P0[r]); }while(0)
  #define RESC() do{ if(resc){ asm volatile("s_waitcnt lgkmcnt(0)":::"memory"); \
      _Pragma("unroll") for(int d_=0;d_<2;++d_) _Pragma("unroll") for(int r=0;r<16;++r)o[d_][r]*=wsf[crow(r,hi)]; } }while(0)
  f32x16 pA0,pA1,pB0,pB1;
  int sl_prev=0,sl_cur=0,sl_next=SLOTB;
  #define ROT() do{sl_prev=sl_cur;sl_cur=sl_next;sl_next=(sl_next==(NSLOT-1)*SLOTB)?0:sl_next+SLOTB;}while(0)
  DMA_K(2,2*SLOTB);
  WAIT_BAR(3);
  qkt(pA0,pA1,Kbase,qr,negm,r32,hi);asm volatile("s_nop 15\n\ts_nop 7":"+v"(pA0),"+v"(pA1));CMASK(pA0,pA1,0);
  START(pA0,pA1);
  _Pragma("unroll") for(int r=0;r<16;++r)pA1[r]=__builtin_amdgcn_exp2f(pA1[r]);
  WAIT_BAR(0);
  DMA_K(3,0);DMA_V(1,SLOTB);
  ROT();
  kload8(kf,kp0+sl_cur);
  WAIT_BAR(2);
  s16x4 vlo[8],vhi[8]; u32x4 pw0,pw1,pw2,pw3;
  #define PKW(P,B) cvtpk_s(P[B],P[B+1])
  #define PAF(k) __builtin_bit_cast(bf16x8,pw##k)
  #define VFR(i) (bf16x8){vlo[i][0],vlo[i][1],vlo[i][2],vlo[i][3],vhi[i][0],vhi[i][1],vhi[i][2],vhi[i][3]}
  #define PIN(x) asm volatile("":"+v"(x))
  #define MX3(a,b,c) __builtin_fmaxf(__builtin_fmaxf((a),(b)),(c))
  #define GAPA(MF,A0,A1,A2,A3,W0,W1,PW) do{ MF; sacc+=A0; sacc+=A1; sacc+=A2; sacc+=A3; PIN(sacc); W0; W1; PIN(PW); SBAR(); }while(0)
  #define EX(v) __builtin_amdgcn_exp2f(v)
  #define GAPB(MF,X,B) do{ MF; X[B]=EX(X[B]); X[B+1]=EX(X[B+1]); X[B+2]=EX(X[B+2]); X[B+3]=EX(X[B+3]); PIN(X); SBAR(); }while(0)
  #define VRD(i) do{ vlo[i]=vtr(vp_+(((i)>>2)*4096+((i)&3)*1024)); vhi[i]=vtr(vp_+(((i)>>2)*4096+((i)&3)*1024+512)); }while(0)
  #define KRD(G,j) do{ if(G){ kload2(kf,kp0+sl_next,j); SBAR(); } }while(0)
  #define STEP(C0,C1,P0,P1,t,GK,GV,GL) do{ SBAR(); \
    const lds_cptr vp_=vp0+sl_prev; \
    VRD(0); SBAR(); float sacc=(P0[0]+P0[1]); \
    GAPA(C0=__builtin_amdgcn_mfma_f32_32x32x16_bf16(kf[0],qr[0],negm,0,0,0), P0[2],P0[3],P0[4],P0[5],     pw0[0]=PKW(P0,0), pw0[1]=PKW(P0,2), pw0); \
    VRD(4); SBAR(); GAPA(C1=__builtin_amdgcn_mfma_f32_32x32x16_bf16(kf[1],qr[0],negm,0,0,0), P0[6],P0[7],P0[8],P0[9],     pw0[2]=PKW(P0,4), pw0[3]=PKW(P0,6), pw0); \
    VRD(1); SBAR(); GAPA(C0=__builtin_amdgcn_mfma_f32_32x32x16_bf16(kf[2],qr[1],C0,0,0,0),   P0[10],P0[11],P0[12],P0[13], pw1[0]=PKW(P0,8), pw1[1]=PKW(P0,10), pw1); \
    VRD(5); SBAR(); GAPA(C1=__builtin_amdgcn_mfma_f32_32x32x16_bf16(kf[3],qr[1],C1,0,0,0),   P0[14],P0[15],P1[0],P1[1],   pw1[2]=PKW(P0,12),pw1[3]=PKW(P0,14), pw1); \
    VRD(2); SBAR(); GAPA(C0=__builtin_amdgcn_mfma_f32_32x32x16_bf16(kf[4],qr[2],C0,0,0,0),   P1[2],P1[3],P1[4],P1[5],     pw2[0]=PKW(P1,0), pw2[1]=PKW(P1,2), pw2); \
    VRD(6); SBAR(); GAPA(C1=__builtin_amdgcn_mfma_f32_32x32x16_bf16(kf[5],qr[2],C1,0,0,0),   P1[6],P1[7],P1[8],P1[9],     pw2[2]=PKW(P1,4), pw2[3]=PKW(P1,6), pw2); \
    VRD(3); SBAR(); GAPA(C0=__builtin_amdgcn_mfma_f32_32x32x16_bf16(kf[6],qr[3],C0,0,0,0),   P1[10],P1[11],P1[12],P1[13], pw3[0]=PKW(P1,8), pw3[1]=PKW(P1,10), pw3); \
    VRD(7); SBAR(); GAPA(C1=__builtin_amdgcn_mfma_f32_32x32x16_bf16(kf[7],qr[3],C1,0,0,0),   P1[14],P1[15],0.f,0.f,       pw3[2]=PKW(P1,12),pw3[3]=PKW(P1,14), pw3); \
    l_reg+=sacc; \
    if(GK){DMA_K((t)+3,sl_cur);} if(GV){DMA_V((t)+1,sl_next);} \
    CMASK(C0,C1,t); \
    { float a=MX3(C0[0],C0[1],C1[0]),b=MX3(C0[2],C0[3],C1[1]); a=MX3(a,C1[2],C1[3]); \
      _Pragma("unroll") for(int r=4;r<16;r+=4){a=MX3(a,C0[r],C0[r+1]);b=MX3(b,C0[r+2],C0[r+3]);a=MX3(a,C1[r],C1[r+1]);b=MX3(b,C1[r+2],C1[r+3]);} \
      float rm=__builtin_fmaxf(a,b); { auto rr=__builtin_amdgcn_permlane32_swap(__float_as_uint(rm),__float_as_uint(rm),false,false); rm=__builtin_fmaxf(__uint_as_float(rr[0]),__uint_as_float(rr[1])); } \
      resc=false; \
      if(__builtin_expect(__any(rm>(float)THRL),0)){ const float dl=__builtin_fmaxf(rm,0.f); mhat+=dl; \
        _Pragma("unroll") for(int r=0;r<16;++r){C0[r]-=dl;C1[r]-=dl;} \
        _Pragma("unroll") for(int r=0;r<16;++r)negm[r]=-mhat; asm volatile("":"+v"(negm)); \
        const float f=__builtin_amdgcn_exp2f(-dl); l_reg*=f; if(hi==0)wsf[r32]=f; resc=true; } } \
    SBAR(); \
    GAPB(o[0]=__builtin_amdgcn_mfma_f32_32x32x16_bf16(PAF(0),VFR(0),o[0],0,0,0), C0,0); \
    GAPB(o[1]=__builtin_amdgcn_mfma_f32_32x32x16_bf16(PAF(0),VFR(4),o[1],0,0,0), C0,4); \
    KRD(GL,0); GAPB(o[0]=__builtin_amdgcn_mfma_f32_32x32x16_bf16(PAF(1),VFR(1),o[0],0,0,0), C0,8); \
    KRD(GL,1); GAPB(o[1]=__builtin_amdgcn_mfma_f32_32x32x16_bf16(PAF(1),VFR(5),o[1],0,0,0), C0,12); \
    KRD(GL,2); GAPB(o[0]=__builtin_amdgcn_mfma_f32_32x32x16_bf16(PAF(2),VFR(2),o[0],0,0,0), C1,0); \
    KRD(GL,3); GAPB(o[1]=__builtin_amdgcn_mfma_f32_32x32x16_bf16(PAF(2),VFR(6),o[1],0,0,0), C1,4); \
    GAPB(o[0]=__builtin_amdgcn_mfma_f32_32x32x16_bf16(PAF(3),VFR(3),o[0],0,0,0), C1,8); \
    GAPB(o[1]=__builtin_amdgcn_mfma_f32_32x32x16_bf16(PAF(3),VFR(7),o[1],0,0,0), C1,12); \
    }while(0)
  int t=1;
  #undef CMASK
  #define CMASK(P0,P1,t) do{}while(0)
  for(;t+5<NT;t+=2){
    STEP(pB0,pB1,pA0,pA1,t,true,true,true);     WAIT_BAR(2); RESC(); ROT();
    STEP(pA0,pA1,pB0,pB1,t+1,true,true,true);   WAIT_BAR(2); RESC(); ROT();
  }
  #undef CMASK
  #define CMASK(P0,P1,t) do{}while(0)
  #define ENDW(tt) do{ if((tt)+3<NT){WAIT_BAR(2);} else if((tt)+2<NT){WAIT_BAR(1);} else {WAIT_BAR(0);} }while(0)
  for(;t+1<NT;t+=2){
    STEP(pB0,pB1,pA0,pA1,t,(t+3<NT),(t+1<NT),(t+1<NT));       ENDW(t);   RESC(); ROT();
    STEP(pA0,pA1,pB0,pB1,t+1,(t+4<NT),(t+2<NT),(t+2<NT));     ENDW(t+1); RESC(); ROT();
  }
  STEP(pB0,pB1,pA0,pA1,NT-1,false,false,false); RESC();
  { float sacc=pB0[0]+pB0[1]; _Pragma("unroll") for(int r=2;r<16;++r)sacc+=pB0[r]; _Pragma("unroll") for(int r=0;r<16;++r)sacc+=pB1[r]; l_reg+=sacc;
    pw0=(u32x4){PKW(pB0,0),PKW(pB0,2),PKW(pB0,4),PKW(pB0,6)};pw1=(u32x4){PKW(pB0,8),PKW(pB0,10),PKW(pB0,12),PKW(pB0,14)};pw2=(u32x4){PKW(pB1,0),PKW(pB1,2),PKW(pB1,4),PKW(pB1,6)};pw3=(u32x4){PKW(pB1,8),PKW(pB1,10),PKW(pB1,12),PKW(pB1,14)};
    SBAR(); pv(o,vb0+sl_cur,PAF(0),PAF(1),PAF(2),PAF(3)); }
  #undef PKW
  #undef PAF
  #undef VFR
  #undef PIN
  #undef MX3
  #undef GAPA
  #undef GAPB
  #undef EX
  #undef VRD
  #undef KRD
  #undef STEP
  #undef ENDW
  {auto rr=__builtin_amdgcn_permlane32_swap(__float_as_uint(l_reg),__float_as_uint(l_reg),false,false);l_reg=__uint_as_float(rr[0])+__uint_as_float(rr[1]);}
  if(hi==0)wsf[32+r32]=l_reg;asm volatile("s_waitcnt lgkmcnt(0)":::"memory");
  float rli[16];
  #pragma unroll
  for(int r=0;r<16;++r)rli[r]=__builtin_amdgcn_rcpf(wsf[32+crow(r,hi)]);
  bf16*Ow=Ou+(long)(wid*QBLK)*OP;
  { bf16*stg=(bf16*)(shm+LDS_OST)+wid*2048;
    #pragma unroll
    for(int r=0;r<16;++r){const int orow=crow(r,hi);
      #pragma unroll
      for(int d0=0;d0<2;++d0)stg[orow*64+d0*32+r32]=__float2bfloat16(o[d0][r]*rli[r]);}
    asm volatile("s_waitcnt lgkmcnt(0)":::"memory");
    #pragma unroll
    for(int i=0;i<4;++i){const int row=i*8+(lane>>3),ch=lane&7; const u32x4 v=*(const u32x4*)(stg+row*64+ch*8); ATTN_STORE16(Ow+(long)row*OP+ch*8,v);} }
  asm volatile("s_waitcnt lgkmcnt(0)\n\ts_barrier":::"memory");
  #undef DMA_K
  #undef DMA_V
  #undef CMASK
  #undef START
  #undef RESC
  #undef ROT
}
#ifndef ATTN_STORE16
#define ATTN_STORE16(p,v) (*(u32x4*)(p)=(v))
#endif
struct NaP { int nW, R0, i0; long jump; const float* rpbs; };
template<int THRL> __device__ __forceinline__ void attn_unit_na(const bf16*Qu,int QP,const bf16*__restrict__ Kh,const bf16*__restrict__ Vh,int KP,int NT,bf16*Ou,int OP,char*shm,const NaP na){
  const int tid=tidx(),lane=tid&63,r32=lane&31,hi=lane>>5; const int wid=__builtin_amdgcn_readfirstlane(tid>>6);
  const bf16*Qw=Qu+(long)(wid*QBLK)*QP;
  const unsigned lds0=(unsigned)(uintptr_t)shm;
  float*wsf=(float*)(shm+LDS_WS)+wid*64;
  const bf16*ksrc=Kh+(long)lane*KP+wid*8;
  const bf16*vsrc=Vh+(long)(16*(wid&3)+(lane>>2))*KP+(wid>>2)*32+(lane&3)*8;
  const unsigned kdst=lds0+LDS_K+wid*1024, vdst=lds0+LDS_V+wid*1024;
  #define NA_TOFF(t) ((long)((t)<na.nW+4?(t):na.nW+3)*KVBLK+((t)>=na.nW?na.jump:0L))
  const int na_qi=na.i0+(wid>>1), na_qc=32*(wid&1)+r32, na_rs=min(max(na_qi-4,0),56), na_cs=min(max(na_qc-8,0),48);
  #define NA_MASK(P0,P1,t) do{ const int t_=(t); if(t_<na.nW){ const int krow_=na.R0+t_; if(krow_<na_rs||krow_>na_rs+7){ _Pragma("unroll") for(int r=0;r<16;++r){P0[r]=-30000.f;P1[r]=-30000.f;} } \
      else { const int dr_=(krow_-na_qi+7)*31+15-na_qc; _Pragma("unroll") for(int r=0;r<16;++r){ const int k0_=crow(r,hi),k1_=k0_+32; const bool v0_=(k0_>=na_cs)&&(k0_<na_cs+16),v1_=(k1_>=na_cs)&&(k1_<na_cs+16); \
          const float b0_=na.rpbs[v0_?dr_+k0_:0],b1_=na.rpbs[v1_?dr_+k1_:0]; P0[r]=v0_?P0[r]+b0_:-30000.f; P1[r]=v1_?P1[r]+b1_:-30000.f; } } } \
    else if(t_>=na.nW+4){ _Pragma("unroll") for(int r=0;r<16;++r){P0[r]=-30000.f;P1[r]=-30000.f;} } }while(0)
  #define DMA_K(t,slot) glds16(ksrc+NA_TOFF(t)*KP,(unsigned)__builtin_amdgcn_readfirstlane(kdst+(slot)))
  #define DMA_V(t,slot) glds16(vsrc+NA_TOFF(t)*KP,(unsigned)__builtin_amdgcn_readfirstlane(vdst+(slot)))
  const int vb0=(int)(lds0+LDS_V)+((lane>>4)&1)*32+(lane&3)*8+(4*hi+((lane&15)>>2))*64;
  const char*Kbase=shm+LDS_K; bf16x8 kf[8];
  const lds_cptr shm3=(lds_cptr)shm; const lds_cptr kp0=shm3+LDS_K+hi*1024+r32*16; const lds_cptr vp0=shm3+LDS_V+((lane>>4)&1)*32+(lane&3)*8+(4*hi+((lane&15)>>2))*64;
  DMA_K(0,0);DMA_V(0,0);DMA_K(1,SLOTB);
  bf16x8 qr[4];
  #pragma unroll
  for(int d0=0;d0<4;++d0)qr[d0]=*reinterpret_cast<const bf16x8*>(&Qw[(long)r32*QP+d0*16+hi*8]);
  float mhat=0.f,l_reg=0.f;f32x16 o[2];o[0]=f32x16{};o[1]=f32x16{};
  const int qrel=wid*QBLK+r32;
  #define CMASK(P0,P1,t) NA_MASK(P0,P1,t)
  bool resc=false;
  #define START(P0,P1) do{ const float rm=rowmax(P0,P1); resc=false; \
    { const float dl=rm; mhat=fadd_s(mhat,dl); \
      _Pragma("unroll") for(int r=0;r<16;++r){P0[r]=fsub_s(P0[r],dl);P1[r]=fsub_s(P1[r],dl);} \
      } \
    _Pragma("unroll") for(int r=0;r<16;++r)P0[r]=__builtin_amdgcn_exp2f(P0[r]); }while(0)
  #define RESC() do{ if(resc){ asm volatile("s_waitcnt lgkmcnt(0)":::"memory"); \
      _Pragma("unroll") for(int d_=0;d_<2;++d_) _Pragma("unroll") for(int r=0;r<16;++r)o[d_][r]*=wsf[crow(r,hi)]; } }while(0)
  f32x16 pA0,pA1,pB0,pB1;
  int sl_prev=0,sl_cur=0,sl_next=SLOTB;
  #define ROT() do{sl_prev=sl_cur;sl_cur=sl_next;sl_next=(sl_next==(NSLOT-1)*SLOTB)?0:sl_next+SLOTB;}while(0)
  DMA_K(2,2*SLOTB);
  WAIT_BAR(3);
  qkt(pA0,pA1,Kbase,qr,f32x16{},r32,hi);asm volatile("s_nop 15\n\ts_nop 7":"+v"(pA0),"+v"(pA1));CMASK(pA0,pA1,0);
  START(pA0,pA1);
  _Pragma("unroll") for(int r=0;r<16;++r)pA1[r]=__builtin_amdgcn_exp2f(pA1[r]);
  WAIT_BAR(0);
  DMA_K(3,0);DMA_V(1,SLOTB);
  ROT();
  kload8(kf,kp0+sl_cur);
  WAIT_BAR(2);
  s16x4 vlo[8],vhi[8]; u32x4 pw0,pw1,pw2,pw3;
  #define PKW(P,B) cvtpk_s(P[B],P[B+1])
  #define PAF(k) __builtin_bit_cast(bf16x8,pw##k)
  #define VFR(i) (bf16x8){vlo[i][0],vlo[i][1],vlo[i][2],vlo[i][3],vhi[i][0],vhi[i][1],vhi[i][2],vhi[i][3]}
  #define PIN(x) asm volatile("":"+v"(x))
  #define MX3(a,b,c) __builtin_fmaxf(__builtin_fmaxf((a),(b)),(c))
  #define GAPA(MF,A0,A1,A2,A3,W0,W1,PW) do{ MF; sacc+=A0; sacc+=A1; sacc+=A2; sacc+=A3; PIN(sacc); W0; W1; PIN(PW); SBAR(); }while(0)
  #define EX(v) __builtin_amdgcn_exp2f(v)
  #define GAPB(MF,X,B) do{ MF; X[B]=EX(X[B]); X[B+1]=EX(X[B+1]); X[B+2]=EX(X[B+2]); X[B+3]=EX(X[B+3]); PIN(X); SBAR(); }while(0)
  #define VRD(i) do{ vlo[i]=vtr(vp_+(((i)>>2)*4096+((i)&3)*1024)); vhi[i]=vtr(vp_+(((i)>>2)*4096+((i)&3)*1024+512)); }while(0)
  #define KRD(G,j) do{ if(G){ kload2(kf,kp0+sl_next,j); SBAR(); } }while(0)
  #define STEP(C0,C1,P0,P1,t,GK,GV,GL) do{ SBAR(); \
    const lds_cptr vp_=vp0+sl_prev; \
    VRD(0); SBAR(); float sacc=(P0[0]+P0[1]); \
    GAPA(C0=__builtin_amdgcn_mfma_f32_32x32x16_bf16(kf[0],qr[0],f32x16{},0,0,0), P0[2],P0[3],P0[4],P0[5],     pw0[0]=PKW(P0,0), pw0[1]=PKW(P0,2), pw0); \
    VRD(4); SBAR(); GAPA(C1=__builtin_amdgcn_mfma_f32_32x32x16_bf16(kf[1],qr[0],f32x16{},0,0,0), P0[6],P0[7],P0[8],P0[9],     pw0[2]=PKW(P0,4), pw0[3]=PKW(P0,6), pw0); \
    VRD(1); SBAR(); GAPA(C0=__builtin_amdgcn_mfma_f32_32x32x16_bf16(kf[2],qr[1],C0,0,0,0),   P0[10],P0[11],P0[12],P0[13], pw1[0]=PKW(P0,8), pw1[1]=PKW(P0,10), pw1); \
    VRD(5); SBAR(); GAPA(C1=__builtin_amdgcn_mfma_f32_32x32x16_bf16(kf[3],qr[1],C1,0,0,0),   P0[14],P0[15],P1[0],P1[1],   pw1[2]=PKW(P0,12),pw1[3]=PKW(P0,14), pw1); \
    VRD(2); SBAR(); GAPA(C0=__builtin_amdgcn_mfma_f32_32x32x16_bf16(kf[4],qr[2],C0,0,0,0),   P1[2],P1[3],P1[4],P1[5],     pw2[0]=PKW(P1,0), pw2[1]=PKW(P1,2), pw2); \
    VRD(6); SBAR(); GAPA(C1=__builtin_amdgcn_mfma_f32_32x32x16_bf16(kf[5],qr[2],C1,0,0,0),   P1[6],P1[7],P1[8],P1[9],     pw2[2]=PKW(P1,4), pw2[3]=PKW(P1,6), pw2); \
    VRD(3); SBAR(); GAPA(C0=__builtin_amdgcn_mfma_f32_32x32x16_bf16(kf[6],qr[3],C0,0,0,0),   P1[10],P1[11],P1[12],P1[13], pw3[0]=PKW(P1,8), pw3[1]=PKW(P1,10), pw3); \
    VRD(7); SBAR(); GAPA(C1=__builtin_amdgcn_mfma_f32_32x32x16_bf16(kf[7],qr[3],C1,0,0,0),   P1[14],P1[15],0.f,0.f,       pw3[2]=PKW(P1,12),pw3[3]=PKW(P1,14), pw3); \
    l_reg+=sacc; \
    if(GK){DMA_K((t)+3,sl_cur);} if(GV){DMA_V((t)+1,sl_next);} \
    { const float mh_=mhat; _Pragma("unroll") for(int r=0;r<16;++r){C0[r]-=mh_;C1[r]-=mh_;} } \
    CMASK(C0,C1,t); \
    { float a=MX3(C0[0],C0[1],C1[0]),b=MX3(C0[2],C0[3],C1[1]); a=MX3(a,C1[2],C1[3]); \
      _Pragma("unroll") for(int r=4;r<16;r+=4){a=MX3(a,C0[r],C0[r+1]);b=MX3(b,C0[r+2],C0[r+3]);a=MX3(a,C1[r],C1[r+1]);b=MX3(b,C1[r+2],C1[r+3]);} \
      float rm=__builtin_fmaxf(a,b); { auto rr=__builtin_amdgcn_permlane32_swap(__float_as_uint(rm),__float_as_uint(rm),false,false); rm=__builtin_fmaxf(__uint_as_float(rr[0]),__uint_as_float(rr[1])); } \
      resc=false; \
      if(__builtin_expect(__any(rm>(float)THRL),0)){ const float dl=__builtin_fmaxf(rm,0.f); mhat+=dl; \
        _Pragma("unroll") for(int r=0;r<16;++r){C0[r]-=dl;C1[r]-=dl;} \
        const float f=__builtin_amdgcn_exp2f(-dl); l_reg*=f; if(hi==0)wsf[r32]=f; resc=true; } } \
    SBAR(); \
    GAPB(o[0]=__builtin_amdgcn_mfma_f32_32x32x16_bf16(PAF(0),VFR(0),o[0],0,0,0), C0,0); \
    GAPB(o[1]=__builtin_amdgcn_mfma_f32_32x32x16_bf16(PAF(0),VFR(4),o[1],0,0,0), C0,4); \
    KRD(GL,0); GAPB(o[0]=__builtin_amdgcn_mfma_f32_32x32x16_bf16(PAF(1),VFR(1),o[0],0,0,0), C0,8); \
    KRD(GL,1); GAPB(o[1]=__builtin_amdgcn_mfma_f32_32x32x16_bf16(PAF(1),VFR(5),o[1],0,0,0), C0,12); \
    KRD(GL,2); GAPB(o[0]=__builtin_amdgcn_mfma_f32_32x32x16_bf16(PAF(2),VFR(2),o[0],0,0,0), C1,0); \
    KRD(GL,3); GAPB(o[1]=__builtin_amdgcn_mfma_f32_32x32x16_bf16(PAF(2),VFR(6),o[1],0,0,0), C1,4); \
    GAPB(o[0]=__builtin_amdgcn_mfma_f32_32x32x16_bf16(PAF(3),VFR(3),o[0],0,0,0), C1,8); \
    GAPB(o[1]=__builtin_amdgcn_mfma_f32_32x32x16_bf16(PAF(3),VFR(7),o[1],0,0,0), C1,12); \
    }while(0)
  int t=1;
  #undef CMASK
  #define CMASK(P0,P1,t) NA_MASK(P0,P1,t)
  for(;t+5<NT;t+=2){
    STEP(pB0,pB1,pA0,pA1,t,true,true,true);     WAIT_BAR(2); RESC(); ROT();
    STEP(pA0,pA1,pB0,pB1,t+1,true,true,true);   WAIT_BAR(2); RESC(); ROT();
  }
  #undef CMASK
  #define CMASK(P0,P1,t) NA_MASK(P0,P1,t)
  #define ENDW(tt) do{ if((tt)+3<NT){WAIT_BAR(2);} else if((tt)+2<NT){WAIT_BAR(1);} else {WAIT_BAR(0);} }while(0)
  for(;t+1<NT;t+=2){
    STEP(pB0,pB1,pA0,pA1,t,(t+3<NT),(t+1<NT),(t+1<NT));       ENDW(t);   RESC(); ROT();
    STEP(pA0,pA1,pB0,pB1,t+1,(t+4<NT),(t+2<NT),(t+2<NT));     ENDW(t+1); RESC(); ROT();
  }
  STEP(pB0,pB1,pA0,pA1,NT-1,false,false,false); RESC();
  { float sacc=pB0[0]+pB0[1]; _Pragma("unroll") for(int r=2;r<16;++r)sacc+=pB0[r]; _Pragma("unroll") for(int r=0;r<16;++r)sacc+=pB1[r]; l_reg+=sacc;
    pw0=(u32x4){PKW(pB0,0),PKW(pB0,2),PKW(pB0,4),PKW(pB0,6)};pw1=(u32x4){PKW(pB0,8),PKW(pB0,10),PKW(pB0,12),PKW(pB0,14)};pw2=(u32x4){PKW(pB1,0),PKW(pB1,2),PKW(pB1,4),PKW(pB1,6)};pw3=(u32x4){PKW(pB1,8),PKW(pB1,10),PKW(pB1,12),PKW(pB1,14)};
    SBAR(); pv(o,vb0+sl_cur,PAF(0),PAF(1),PAF(2),PAF(3)); }
  #undef PKW
  #undef PAF
  #undef VFR
  #undef PIN
  #undef MX3
  #undef GAPA
  #undef GAPB
  #undef EX
  #undef VRD
  #undef KRD
  #undef STEP
  #undef ENDW
  {auto rr=__builtin_amdgcn_permlane32_swap(__float_as_uint(l_reg),__float_as_uint(l_reg),false,false);l_reg=__uint_as_float(rr[0])+__uint_as_float(rr[1]);}
  if(hi==0)wsf[32+r32]=l_reg;asm volatile("s_waitcnt lgkmcnt(0)":::"memory");
  float rli[16];
  #pragma unroll
  for(int r=0;r<16;++r)rli[r]=__builtin_amdgcn_rcpf(wsf[32+crow(r,hi)]);
  bf16*Ow=Ou+(long)(wid*QBLK)*OP;
  { bf16*stg=(bf16*)(shm+LDS_OST)+wid*2048;
    #pragma unroll
    for(int r=0;r<16;++r){const int orow=crow(r,hi);
      #pragma unroll
      for(int d0=0;d0<2;++d0)stg[orow*64+d0*32+r32]=__float2bfloat16(o[d0][r]*rli[r]);}
    asm volatile("s_waitcnt lgkmcnt(0)":::"memory");
    #pragma unroll
    for(int i=0;i<4;++i){const int row=i*8+(lane>>3),ch=lane&7; const u32x4 v=*(const u32x4*)(stg+row*64+ch*8); ATTN_STORE16(Ow+(long)row*OP+ch*8,v);} }
  asm volatile("s_waitcnt lgkmcnt(0)\n\ts_barrier":::"memory");
  #undef NA_TOFF
  #undef NA_MASK
  #undef DMA_K
  #undef DMA_V
  #undef CMASK
  #undef START
  #undef RESC
  #undef ROT
}
#undef SBAR
#undef WAIT_BAR
}
#define LAS __attribute__((address_space(3)))
#define XB_TMO      128
#define XB_XCNT(j)  (256  + 64 * (j))
#define XB_XSUB(j)  (1280 + 64 * (j))
#define XB_XGEN(j)  (2304 + 64 * (j))
#define XB_TOP      3328
#define XB_TOPGEN   3392
#define XCD_BAR_WORDS 3456
#define XB_SPIN_CAP (1u << 18)

__device__ __forceinline__ unsigned xb_ld(unsigned* p)              { return __hip_atomic_load(p, __ATOMIC_RELAXED, __HIP_MEMORY_SCOPE_AGENT); }
__device__ __forceinline__ unsigned xb_add(unsigned* p, unsigned v) { return __hip_atomic_fetch_add(p, v, __ATOMIC_RELAXED, __HIP_MEMORY_SCOPE_AGENT); }
__device__ __forceinline__ unsigned xb_xcc_id() { return (unsigned)__builtin_amdgcn_s_getreg((3 << 11) | 20) & 0xFu; }
#define XB_SPIN(cond, bar) do { unsigned _sp = 0; while (cond) { __builtin_amdgcn_s_sleep(1); \
    if ((++_sp & 255u) == 0u) { if (xb_ld(&(bar)[XB_TMO])) break; if (_sp > XB_SPIN_CAP) { atomicAdd(&(bar)[XB_TMO], 1u); break; } } } } while (0)

struct XcdBarrier {
    unsigned* bar; unsigned x;
    volatile LAS unsigned* st;
};

__device__ __forceinline__ XcdBarrier xcd_barrier_post(unsigned* bar, volatile LAS unsigned* st) {
    XcdBarrier b; b.bar = bar; b.x = xb_xcc_id(); b.st = st;
    if (threadIdx.x == 0) (void)xb_add(&bar[XB_XCNT(b.x)], 1u);
    return b;
}
__device__ __forceinline__ void xcd_barrier_complete(unsigned* bar, unsigned x, unsigned& nloc, unsigned& nx) {
    const unsigned G = gridDim.x * gridDim.y * gridDim.z;
    unsigned sum, cnt, mine, sp = 0u;
    for (;;) {
        sum = 0u; cnt = 0u; mine = 0u;
#pragma unroll
        for (unsigned j = 0; j < 16; ++j) { const unsigned c = xb_ld(&bar[XB_XCNT(j)]); sum += c; cnt += (c > 0u) ? 1u : 0u; mine = (j == x) ? c : mine; }
        if (sum == G) break;
        __builtin_amdgcn_s_sleep(1);
        if ((++sp & 255u) == 0u) { if (xb_ld(&bar[XB_TMO])) break; if (sp > XB_SPIN_CAP) { atomicAdd(&bar[XB_TMO], 1u); break; } }
    }
    nloc = mine > 0u ? mine : 1u; nx = cnt > 0u ? cnt : 1u;
}

__device__ __forceinline__ void xcd_barrier(const XcdBarrier& b) {
    asm volatile("s_waitcnt vmcnt(0)" ::: "memory");
    __syncthreads();
    if (threadIdx.x == 0) {
        unsigned* bar = b.bar;
        __builtin_amdgcn_s_waitcnt(0);
        unsigned nloc = b.st[0], nx = b.st[1];
        if (nloc == 0u) { xcd_barrier_complete(bar, b.x, nloc, nx); b.st[0] = nloc; b.st[1] = nx; }
        const unsigned old = xb_add(&bar[XB_XSUB(b.x)], 1u);
        const unsigned gen = old / nloc;
        if (old + 1u == (gen + 1u) * nloc) {
            __builtin_amdgcn_fence(__ATOMIC_RELEASE, "agent");
            asm volatile("s_waitcnt vmcnt(0)" ::: "memory");
            const unsigned og = xb_add(&bar[XB_TOP], 1u);
            const unsigned tg = og / nx;
            if (og + 1u == (tg + 1u) * nx) xb_add(&bar[XB_TOPGEN], 1u);
            else XB_SPIN(xb_ld(&bar[XB_TOPGEN]) == tg, bar);
            __builtin_amdgcn_fence(__ATOMIC_ACQUIRE, "agent");
            xb_add(&bar[XB_XGEN(b.x)], 1u);
            asm volatile("s_waitcnt vmcnt(0)" ::: "memory");
        } else {
            XB_SPIN(xb_ld(&bar[XB_XGEN(b.x)]) == gen, bar);
            __builtin_amdgcn_fence(__ATOMIC_ACQUIRE, "agent");
            asm volatile("s_waitcnt vmcnt(0)" ::: "memory");
        }
    }
    __syncthreads();
}
typedef unsigned short bf16_t;
typedef float f32x4 __attribute__((ext_vector_type(4)));
typedef float f32x2 __attribute__((ext_vector_type(2)));
typedef unsigned u32x4 __attribute__((ext_vector_type(4)));
typedef unsigned u32x2 __attribute__((ext_vector_type(2)));
constexpr int NB = 4, SEQ = 4096, CTX = 256, DM = 2048, NLAT = NB * SEQ, NCTX = NB * CTX, NT = NLAT + NCTX;
constexpr int INP = 5120;
constexpr int KVLEN = SEQ + CTX;
constexpr float LOG2E = 1.4426950408889634f;
constexpr size_t MiB = 1u << 20;
constexpr size_t WS_CTL = 0, WS_MOD = 1 * MiB, WS_CTXR = 2 * MiB, WS_WIN = 10 * MiB, WS_WO0 = 30 * MiB, WS_W10 = 38 * MiB, WS_W20 = 70 * MiB,
                 WS_WQKV = 102 * MiB, WS_WO1 = 126 * MiB, WS_W11 = 134 * MiB, WS_W21 = 166 * MiB, WS_BP = 198 * MiB, WS_H = 204 * MiB,
                 WS_P = 272 * MiB, WS_XR = 442 * MiB, WS_XK = 476 * MiB, WS_XV = 510 * MiB, WS_KK = 544 * MiB, WS_AP = 578 * MiB,
                 WS_KALL = 595 * MiB, WS_VALL = 604 * MiB, WS_XRB = 613 * MiB  , WS_END = 677 * MiB;
constexpr size_t WS_ZB = 1 * MiB + 512 * 1024;
constexpr size_t WS_PART = 544 * MiB;
constexpr size_t WS_U = 272 * MiB;
constexpr size_t WS_Q1 = 272 * MiB, WS_K1 = 340 * MiB, WS_V1 = 408 * MiB, WS_O1 = 476 * MiB;
constexpr size_t DO_YF = 0, DO_YB = 34 * MiB, DO_Q0 = 68 * MiB;
constexpr int LDS_BYTES = 147456;

__device__ __forceinline__ float bf2f(bf16_t v) { return __uint_as_float((unsigned)v << 16); }
__device__ __forceinline__ unsigned f2bf(float f) { unsigned u = __float_as_uint(f); return (u + 0x7fffu + ((u >> 16) & 1u)) >> 16; }
__device__ __forceinline__ unsigned pk2(float lo, float hi) { return f2bf(lo) | (f2bf(hi) << 16); }
__device__ __forceinline__ float wave_sum(float v) {
#pragma unroll
    for (int o = 1; o < 64; o <<= 1) v += __shfl_xor(v, o);
    return v;
}
__device__ __forceinline__ float sigm(float x) { return 1.f / (1.f + __expf(-x)); }

struct Args {
    const float* in[39]; float* out; unsigned char* ws; int grid; int pad;
};


typedef __attribute__((address_space(4))) const Args KArgs;
__device__ __forceinline__ const float* kin(int i) { KArgs* k = (KArgs*)__builtin_amdgcn_kernarg_segment_ptr(); return *(const float* const volatile __attribute__((address_space(4)))*)&k->in[i]; }
__device__ __forceinline__ unsigned char* kws() { KArgs* k = (KArgs*)__builtin_amdgcn_kernarg_segment_ptr(); return *(unsigned char* const volatile __attribute__((address_space(4)))*)&k->ws; }
__device__ __forceinline__ float* kout() { KArgs* k = (KArgs*)__builtin_amdgcn_kernarg_segment_ptr(); return *(float* const volatile __attribute__((address_space(4)))*)&k->out; }
__device__ __forceinline__ void transpose_item(const float* W, int K, int N, bf16_t* WT, float* scr, int item, int lane) {
    const int nblk = N / 32, kb = item / nblk, nb = item % nblk, k0 = 64 * kb, n0 = 32 * nb;
    const int r = lane >> 3, c4 = lane & 7;
    f32x4 v[8];
#pragma unroll
    for (int i = 0; i < 8; ++i) v[i] = __builtin_nontemporal_load((const f32x4*)(W + (size_t)(k0 + 8 * i + r) * N + n0 + 4 * c4));
#pragma unroll
    for (int i = 0; i < 8; ++i) { float* d = scr + (8 * i + r) * 33 + 4 * c4; d[0] = v[i].x; d[1] = v[i].y; d[2] = v[i].z; d[3] = v[i].w; }
    __builtin_amdgcn_wave_barrier(); asm volatile("s_waitcnt lgkmcnt(0)" ::: "memory");
    const int c = lane & 7;
#pragma unroll
    for (int j = 0; j < 4; ++j) { const int n = (lane >> 3) + 8 * j; const float* s = scr + (8 * c) * 33 + n;
        u32x4 o; o.x = pk2(s[0 * 33], s[1 * 33]); o.y = pk2(s[2 * 33], s[3 * 33]); o.z = pk2(s[4 * 33], s[5 * 33]); o.w = pk2(s[6 * 33], s[7 * 33]);
        *(u32x4*)(WT + (size_t)(n0 + n) * K + k0 + 8 * c) = o; }
    __builtin_amdgcn_wave_barrier(); asm volatile("s_waitcnt lgkmcnt(0)" ::: "memory");
}

constexpr int TQ_ITEMS = 2 * (32 * 64) + 2 * (32 * 256) + 2 * (128 * 64) + 32 * 192;
__device__ __forceinline__ void transpose_deferred(int r, float* scr, int lane) {
    constexpr int I_O = 32 * 64, I_W1 = 32 * 256, I_W2 = 128 * 64, I_QKV = 32 * 192;
    if (r < I_O) { transpose_item(kin(26), 2048, 2048, (bf16_t*)(kws() + WS_WO0), scr, r, lane); return; } r -= I_O;
    if (r < I_W1) { transpose_item(kin(27), 2048, 8192, (bf16_t*)(kws() + WS_W10), scr, r, lane); return; } r -= I_W1;
    if (r < I_W2) { transpose_item(kin(28), 8192, 2048, (bf16_t*)(kws() + WS_W20), scr, r, lane); return; } r -= I_W2;
    if (r < I_QKV) { transpose_item(kin(33), 2048, 6144, (bf16_t*)(kws() + WS_WQKV), scr, r, lane); return; } r -= I_QKV;
    if (r < I_O) { transpose_item(kin(35), 2048, 2048, (bf16_t*)(kws() + WS_WO1), scr, r, lane); return; } r -= I_O;
    if (r < I_W1) { transpose_item(kin(36), 2048, 8192, (bf16_t*)(kws() + WS_W11), scr, r, lane); return; } r -= I_W1;
    transpose_item(kin(37), 8192, 2048, (bf16_t*)(kws() + WS_W21), scr, r, lane);
}
__device__ __forceinline__ void phase_prologue(unsigned char* shm) {
    const int tid = tidx(), lane = tid & 63, wid = tid >> 6, G = gridDim.x;
    float* st = (float*)(shm + 73728);
    float* red = (float*)(shm + 73728 + 40960);
    const float* cvec = kin(1); const float* cctx = kin(3);
    for (int i = tid; i < 5 * 2048; i += 512) { const int r = i >> 11, k = i & 2047; const float x = r < 4 ? cvec[r * 2048 + k] : cctx[k]; st[i] = x / (1.f + __expf(-x)); }
    __syncthreads();
    float* mod = (float*)(kws() + WS_MOD);
    for (int item = blockIdx.x; item < 768; item += G) {
        const int layer = item / 384, cch = item % 384, cl = tid & 31, kr = tid >> 5, col = cch * 32 + cl;
        const float* W = layer ? kin(31) : kin(6); const float* bias = layer ? kin(32) : kin(7);
        float acc[5] = {0.f, 0.f, 0.f, 0.f, 0.f};
#pragma unroll 32
        for (int i = 0; i < 128; ++i) { const int k = kr + 16 * i; const float w = __builtin_nontemporal_load(W + (size_t)k * 12288 + col);
#pragma unroll
            for (int r = 0; r < 5; ++r) acc[r] += st[r * 2048 + k] * w; }
#pragma unroll
        for (int r = 0; r < 5; ++r) red[(kr * 5 + r) * 32 + cl] = acc[r];
        __syncthreads();
        if (tid < 160) { const int r = tid >> 5; float s = 0.f;
#pragma unroll
            for (int q = 0; q < 16; ++q) s += red[(q * 5 + r) * 32 + cl];
            mod[(size_t)(layer * 5 + r) * 12288 + col] = s + bias[col]; }
        __syncthreads();
    }
    float* scr = (float*)(shm + wid * 8448);
    const int gw = blockIdx.x * 8 + wid, NGW = G * 8;
    for (int it = gw; it < 32 * 157; it += NGW) transpose_item(kin(8), 2048, 5024, (bf16_t*)(kws() + WS_WIN), scr, it, lane);
    const int gt = blockIdx.x * 512 + tid, GT = G * 512;
    { u32x4* z = (u32x4*)(kws() + WS_WIN + (size_t)5024 * 2048 * 2); for (int i = gt; i < 96 * 2048 * 2 / 16; i += GT) z[i] = (u32x4){0u, 0u, 0u, 0u}; }
    { float* ZB = (float*)(kws() + WS_ZB); for (int i = gt; i < 5120; i += GT) { const int blk = i >> 10, nn = i & 1023; ZB[i] = blk == 0 ? kin(10)[nn] : blk == 1 ? kin(11)[nn] : blk == 2 ? kin(14)[nn] : blk == 3 ? kin(15)[nn] : 0.f; } }
    { bf16_t* BP = (bf16_t*)(kws() + WS_BP);
      for (int i = gt; i < 5120 * 64; i += GT) { const int n = i % 5120, kc = i / 5120, blk = n >> 10, nn = n & 1023;
          const float* W = blk == 0 ? kin(12) : blk == 1 ? kin(13) : blk == 2 ? kin(16) : blk == 3 ? kin(17) : kin(18);
          const int klo = blk * 64, khi = blk == 4 ? 416 : klo + 64; float v[8];
#pragma unroll
          for (int e = 0; e < 8; ++e) { const int k = kc * 8 + e; v[e] = (k >= klo && k < khi) ? W[(size_t)(k - klo) * 1024 + nn] : 0.f; }
          u32x4 o; o.x = pk2(v[0], v[1]); o.y = pk2(v[2], v[3]); o.z = pk2(v[4], v[5]); o.w = pk2(v[6], v[7]);
          *(u32x4*)(BP + (size_t)n * 512 + kc * 8) = o; } }
}

__device__ __forceinline__ void phase_norm_mod(const float* srcL, const float* srcC, const float* g, const float* mod_sh, const float* mod_sc, bf16_t* dst, int nrows, const float* part = nullptr, const float* pgate = nullptr, const bf16_t* srcLb = nullptr) {
    const int tid = tidx(), lane = tid & 63, wid = tid >> 6; const int gw = blockIdx.x * 8 + wid, NGW = gridDim.x * 8;
    for (int row = gw; row < nrows; row += NGW) {
        const bool isc = row >= NLAT; const float* src = isc ? srcC + (size_t)(row - NLAT) * DM : srcL + (size_t)row * DM; const int ridx = isc ? 4 : (row >> 12);
        f32x4 v[8]; float s = 0.f;
#pragma unroll
        for (int j = 0; j < 8; ++j) {
            if (srcLb != nullptr && !isc) { const unsigned long long w = *(const unsigned long long*)(srcLb + (size_t)row * DM + j * 256 + lane * 4); const unsigned lo = (unsigned)w, hi = (unsigned)(w >> 32);
                v[j] = (f32x4){__uint_as_float(lo << 16), __uint_as_float(lo & 0xffff0000u), __uint_as_float(hi << 16), __uint_as_float(hi & 0xffff0000u)}; }
            else if (srcLb == nullptr && !isc) v[j] = __builtin_nontemporal_load((const f32x4*)(src + j * 256 + lane * 4));
            else v[j] = *(const f32x4*)(src + j * 256 + lane * 4);
            if (part != nullptr && isc) { const size_t po = (size_t)(row - NLAT) * DM + j * 256 + lane * 4; f32x4 ps = *(const f32x4*)(part + po);
#pragma unroll
                for (int p = 1; p < 8; ++p) ps = ps + *(const f32x4*)(part + (size_t)p * (1024 * 2048) + po);
                v[j] = v[j] + ps * *(const f32x4*)(pgate + 4 * 12288 + j * 256 + lane * 4); }
            s += (v[j].x * v[j].x + v[j].y * v[j].y) + (v[j].z * v[j].z + v[j].w * v[j].w); }
        const float rstd = rsqrtf(wave_sum(s) * (1.f / DM) + 1e-6f);
        const float* sh = mod_sh + (size_t)ridx * 12288; const float* sc = mod_sc + (size_t)ridx * 12288;
#pragma unroll
        for (int j = 0; j < 8; ++j) { const int c = j * 256 + lane * 4; const f32x4 gv = *(const f32x4*)(g + c), shv = *(const f32x4*)(sh + c), scv = *(const f32x4*)(sc + c);
            const f32x4 y = (v[j] * rstd) * gv; const f32x4 h = y * (scv + 1.f) + shv;
            u32x2 o; o.x = pk2(h.x, h.y); o.y = pk2(h.z, h.w); *(u32x2*)(dst + (size_t)row * DM + c) = o; }
    }
}
__device__ __forceinline__ void phase_final_norm(float* out, const float* g, int nrows, const bf16_t* xb) {
    const int tid = tidx(), lane = tid & 63, wid = tid >> 6; const int gw = blockIdx.x * 8 + wid, NGW = gridDim.x * 8;
    for (int row = gw; row < nrows; row += NGW) {
        const bf16_t* src = xb + (size_t)row * DM; float* dst = out + (size_t)row * DM; f32x4 v[8]; float s = 0.f;
#pragma unroll
        for (int j = 0; j < 8; ++j) { const unsigned long long w = *(const unsigned long long*)(src + j * 256 + lane * 4); const unsigned lo = (unsigned)w, hi = (unsigned)(w >> 32);
            v[j] = (f32x4){__uint_as_float(lo << 16), __uint_as_float(lo & 0xffff0000u), __uint_as_float(hi << 16), __uint_as_float(hi & 0xffff0000u)};
            s += (v[j].x * v[j].x + v[j].y * v[j].y) + (v[j].z * v[j].z + v[j].w * v[j].w); }
        const float rstd = rsqrtf(wave_sum(s) * (1.f / DM) + 1e-6f);
#pragma unroll
        for (int j = 0; j < 8; ++j) { const int c = j * 256 + lane * 4; const f32x4 gv = *(const f32x4*)(g + c); *(f32x4*)(dst + c) = (v[j] * rstd) * gv; }
    }
}

template <int CTRL> __device__ __forceinline__ float dppf(float x) { return __builtin_bit_cast(float, __builtin_amdgcn_mov_dpp(__builtin_bit_cast(int, x), CTRL, 0xf, 0xf, true)); }
__device__ __forceinline__ float red8(float x) { x += dppf<0xB1>(x); x += dppf<0x4E>(x); x += dppf<0x141>(x); return x; }
__device__ __forceinline__ void unpack8(const u32x4 v, float (&x)[8]) {
    x[0] = __uint_as_float(v.x << 16); x[1] = __uint_as_float(v.x & 0xffff0000u); x[2] = __uint_as_float(v.y << 16); x[3] = __uint_as_float(v.y & 0xffff0000u);
    x[4] = __uint_as_float(v.z << 16); x[5] = __uint_as_float(v.z & 0xffff0000u); x[6] = __uint_as_float(v.w << 16); x[7] = __uint_as_float(v.w & 0xffff0000u);
}
__device__ __forceinline__ u32x4 pack8(const float (&x)[8]) { u32x4 o; o.x = pk2(x[0], x[1]); o.y = pk2(x[2], x[3]); o.z = pk2(x[4], x[5]); o.w = pk2(x[6], x[7]); return o; }
__device__ __forceinline__ void phase_prep0() {
    const int tid = tidx(), lane = tid & 63, wid = tid >> 6, l7 = lane & 7; const int gw = blockIdx.x * 8 + wid, NGW = gridDim.x * 8;
    const bf16_t* P = (const bf16_t*)(kws() + WS_P);
    bf16_t* Q0 = (bf16_t*)((unsigned char*)kout() + DO_Q0); bf16_t* KALL = (bf16_t*)(kws() + WS_KALL); bf16_t* VALL = (bf16_t*)(kws() + WS_VALL);
    bf16_t* XR = (bf16_t*)(kws() + WS_XR); bf16_t* XK = (bf16_t*)(kws() + WS_XK); bf16_t* XV = (bf16_t*)(kws() + WS_XV); bf16_t* KK = (bf16_t*)(kws() + WS_KK); bf16_t* AP = (bf16_t*)(kws() + WS_AP);
    float muv[7][8], kkc[2][8], qn[8], kn[8];
    { const float* mu = kin(9); const float* k_k = kin(19); const float* qnp = kin(24); const float* knp = kin(25);
#pragma unroll
      for (int p = 0; p < 7; ++p)
#pragma unroll
          for (int e = 0; e < 8; ++e) { const int c = p * 512 + lane * 8 + e; muv[p][e] = c < 3488 ? mu[c] : 0.f; }
#pragma unroll
      for (int p = 0; p < 2; ++p)
#pragma unroll
          for (int e = 0; e < 8; ++e) kkc[p][e] = k_k[p * 512 + lane * 8 + e];
#pragma unroll
      for (int e = 0; e < 8; ++e) { qn[e] = qnp[l7 * 8 + e]; kn[e] = knp[l7 * 8 + e]; } }
    for (int row = gw; row < NT; row += NGW) {
        const bf16_t* prow = P + (size_t)row * INP;
        const bool isc = row >= NLAT; int b, t = 0, s = 0, grow = 0, gcol = 0;
        if (!isc) { b = row >> 12; t = row & 4095; grow = t >> 6; gcol = t & 63; } else { b = (row - NLAT) >> 8; s = (row - NLAT) & 255; }
        float cs[8], sn[8];
#pragma unroll
        for (int e = 0; e < 8; ++e) { cs[e] = 1.f; sn[e] = 0.f; }
        if (!isc) {
#pragma unroll
            for (int e = 0; e < 8; ++e) { const int i = 8 * (l7 & 3) + e, mm = i & 15; const float pos = (float)(i < 16 ? grow : gcol); const float ang = pos * exp2f(-(float)mm * 0.8304820237218406f); cs[e] = cosf(ang); sn[e] = sinf(ang); } }
        const int kvpos = isc ? SEQ + s : t;
#pragma unroll
        for (int p = 0; p < 3; ++p) {
            const u32x4 raw = *(const u32x4*)(prow + p * 512 + lane * 8); float x[8]; unpack8(raw, x);
            float ss = 0.f;
#pragma unroll
            for (int e = 0; e < 8; ++e) ss += x[e] * x[e];
            ss = red8(ss); const float rs = rsqrtf(ss * (1.f / 64.f) + 1e-6f);
            float y[8];
#pragma unroll
            for (int e = 0; e < 8; ++e) y[e] = x[e] * rs * (p < 2 ? qn[e] : kn[e]);
            if (!isc) {
#pragma unroll
                for (int e = 0; e < 8; ++e) { const float o = __shfl_xor(y[e], 4); y[e] = (l7 < 4) ? y[e] * cs[e] - o * sn[e] : y[e] * cs[e] + o * sn[e]; } }
            if (p < 2) {
#pragma unroll
                for (int e = 0; e < 8; ++e) y[e] *= 0.125f * LOG2E;
                *(u32x4*)(Q0 + (size_t)row * 1024 + p * 512 + lane * 8) = pack8(y);
            } else {
                const size_t kvo = ((size_t)(b * 4 + ((lane >> 3) & 3)) * KVLEN + kvpos) * 64 + l7 * 8;
                if (lane < 32) *(u32x4*)(KALL + kvo) = pack8(y);
                else *(u32x4*)(VALL + kvo) = raw;
            }
        }
        bool val[4]; const bf16_t* nrw[4];
        if (!isc) { val[0] = gcol > 0; val[1] = gcol < 63; val[2] = grow > 0; val[3] = grow < 63; nrw[0] = prow - INP; nrw[1] = prow + INP; nrw[2] = prow - 64 * INP; nrw[3] = prow + 64 * INP; }
        else { val[0] = val[2] = s > 0; val[1] = val[3] = s < 255; nrw[0] = nrw[2] = prow - INP; nrw[1] = nrw[3] = prow + INP; }
#pragma unroll
        for (int p = 0; p < 7; ++p) {
            const int c0 = 1536 + p * 512 + lane * 8;
            float cur[8], nb[4][8];
            unpack8(*(const u32x4*)(prow + c0), cur);
#pragma unroll
            for (int d = 0; d < 4; ++d) { u32x4 nv = (u32x4){0u, 0u, 0u, 0u}; if (val[d]) nv = *(const u32x4*)(nrw[d] + c0); unpack8(nv, nb[d]); }
            float xm[8];
#pragma unroll
            for (int e = 0; e < 8; ++e) xm[e] = cur[e] + muv[p][e] * (nb[e & 3][e] - cur[e]);
            if (p < 2) *(u32x4*)(XR + (size_t)row * 1024 + p * 512 + lane * 8) = pack8(xm);
            else if (p < 4) { *(u32x4*)(XK + (size_t)row * 1024 + (p - 2) * 512 + lane * 8) = pack8(xm);
                float t2[8]; float ss = 0.f;
#pragma unroll
                for (int e = 0; e < 8; ++e) { t2[e] = xm[e] * kkc[p - 2][e]; ss += t2[e] * t2[e]; }
                ss = red8(ss); const float rs = rsqrtf(fmaxf(ss, 1e-12f));
#pragma unroll
                for (int e = 0; e < 8; ++e) t2[e] *= rs;
                *(u32x4*)(KK + (size_t)row * 1024 + (p - 2) * 512 + lane * 8) = pack8(t2); }
            else if (p < 6) *(u32x4*)(XV + (size_t)row * 1024 + (p - 4) * 512 + lane * 8) = pack8(xm);
            else { float o[8]; const int a0 = lane * 8;
#pragma unroll
                for (int e = 0; e < 8; ++e) o[e] = a0 < 128 ? tanhf(xm[e]) : a0 < 256 ? xm[e] : a0 < 416 ? sigm(xm[e]) : 0.f;
                *(u32x4*)(AP + (size_t)row * 512 + a0) = pack8(o); }
        }
    }
}

__device__ __forceinline__ void phase_finish0() {
    const int tid = tidx(), lane = tid & 63, wid = tid >> 6; const int gw = blockIdx.x * 8 + wid, NGW = gridDim.x * 8;
    const bf16_t* YF = (const bf16_t*)((unsigned char*)kout() + DO_YF); const bf16_t* YB = (const bf16_t*)((unsigned char*)kout() + DO_YB);
    const bf16_t* XR = (const bf16_t*)(kws() + WS_XR); const bf16_t* XK = (const bf16_t*)(kws() + WS_XK); const bf16_t* XV = (const bf16_t*)(kws() + WS_XV);
    const bf16_t* Z = (const bf16_t*)(kws() + WS_P); bf16_t* OC = (bf16_t*)(kws() + WS_H);
    float kac[2][8], rkc[2][8], lgc[2][8], lbc[2][8];
    { const float* k_a = kin(20); const float* r_k = kin(21); const float* lg = kin(22); const float* lb = kin(23);
#pragma unroll
      for (int p = 0; p < 2; ++p)
#pragma unroll
          for (int e = 0; e < 8; ++e) { const int c = p * 512 + lane * 8 + e; kac[p][e] = k_a[c]; rkc[p][e] = r_k[c]; lgc[p][e] = lg[c]; lbc[p][e] = lb[c]; } }
    for (int row = gw; row < NT; row += NGW) {
#pragma unroll
        for (int p = 0; p < 2; ++p) { const int c0 = p * 512 + lane * 8; const size_t o = (size_t)row * 1024 + c0; const bf16_t* zr = Z + (size_t)row * INP + c0;
            float yf[8], yb[8], r[8], k[8], v[8], icf[8], icb[8], gt[8];
            unpack8(*(const u32x4*)(YF + o), yf); unpack8(*(const u32x4*)(YB + o), yb); unpack8(*(const u32x4*)(XR + o), r); unpack8(*(const u32x4*)(XK + o), k); unpack8(*(const u32x4*)(XV + o), v);
            unpack8(*(const u32x4*)(zr + 2048), icf); unpack8(*(const u32x4*)(zr + 3072), icb); unpack8(*(const u32x4*)(zr + 4096), gt);
            float y[8], sm = 0.f, bs = 0.f;
#pragma unroll
            for (int e = 0; e < 8; ++e) { y[e] = yf[e] + yb[e]; sm += y[e]; bs += r[e] * k[e] * (2.f + (icf[e] + icb[e] - 2.f) * kac[p][e]) * rkc[p][e]; }
            const float mean = red8(sm) * (1.f / 64.f); bs = red8(bs); float vs = 0.f;
#pragma unroll
            for (int e = 0; e < 8; ++e) { y[e] -= mean; vs += y[e] * y[e]; }
            const float rstd = rsqrtf(red8(vs) * (1.f / 64.f) + 64e-5f); float ov[8];
#pragma unroll
            for (int e = 0; e < 8; ++e) ov[e] = (y[e] * rstd * lgc[p][e] + lbc[p][e] + bs * v[e]) * gt[e];
            *(u32x4*)(OC + (size_t)row * 2048 + 1024 + c0) = pack8(ov); }
    }
}

__device__ __forceinline__ float allred8(float x) {
    x += dppf<0x128>(x);
    auto s = __builtin_amdgcn_permlane16_swap(__float_as_uint(x), __float_as_uint(x), false, false); x = __uint_as_float(s[0]) + __uint_as_float(s[1]);
    auto t = __builtin_amdgcn_permlane32_swap(__float_as_uint(x), __float_as_uint(x), false, false); return __uint_as_float(t[0]) + __uint_as_float(t[1]);
}
__device__ __forceinline__ float allred4(float x) {
    auto s = __builtin_amdgcn_permlane16_swap(__float_as_uint(x), __float_as_uint(x), false, false); x = __uint_as_float(s[0]) + __uint_as_float(s[1]);
    auto t = __builtin_amdgcn_permlane32_swap(__float_as_uint(x), __float_as_uint(x), false, false); return __uint_as_float(t[0]) + __uint_as_float(t[1]);
}
__device__ __forceinline__ void scan_block(unsigned char* shm, int sid, int half) {
    const int tid = tidx(), lane = tid & 63, wid = __builtin_amdgcn_readfirstlane(tid >> 6), nr = lane >> 4, g = lane & 15, rowl = wid * 4 + nr;
    const int dir = sid >> 6, b = (sid >> 4) & 3, h = sid & 15;
    const bf16_t* XR = (const bf16_t*)(kws() + WS_XR); const bf16_t* XK = (const bf16_t*)(kws() + WS_XK); const bf16_t* XV = (const bf16_t*)(kws() + WS_XV); const bf16_t* KK = (const bf16_t*)(kws() + WS_KK);
    const bf16_t* Z = (const bf16_t*)(kws() + WS_P);
    bf16_t* Y = (bf16_t*)((unsigned char*)kout() + (dir ? DO_YB : DO_YF));
    constexpr int TS = 32, NCH = (CTX + SEQ) / TS;
    float* bufs = (float*)shm;
    float* yst = (float*)(shm + 98304);
    const int ss = tid >> 4, part = tid & 15;
    float ka[4];
#pragma unroll
    for (int e = 0; e < 4; ++e) ka[e] = kin(20)[h * 64 + 4 * part + e];
    u32x2 lr, lk, lv, lkk, le, li;
#define SCAN_ROW(gs) ((gs) < CTX ? (NLAT + b * CTX + (dir ? CTX - 1 - (gs) : (gs))) : (b * SEQ + (dir ? SEQ - 1 - ((gs) - CTX) : ((gs) - CTX))))
#define SCAN_LOAD(c) do { const int row_ = SCAN_ROW((c) * TS + ss); const size_t o_ = (size_t)row_ * 1024 + h * 64 + 4 * part; const size_t z_ = (size_t)row_ * INP + dir * 1024 + h * 64 + 4 * part; \
        lr = *(const u32x2*)(XR + o_); lk = *(const u32x2*)(XK + o_); lv = *(const u32x2*)(XV + o_); lkk = *(const u32x2*)(KK + o_); le = *(const u32x2*)(Z + z_); li = *(const u32x2*)(Z + z_ + 2048); } while (0)
#define BFLO(u) __uint_as_float((u) << 16)
#define BFHI(u) __uint_as_float((u) & 0xffff0000u)
#define SCAN_STORE(c) do { float* bb_ = bufs + ((c) & 1) * 12288 + ss * 64 + 4 * part; \
        const f32x4 r_ = {BFLO(lr.x), BFHI(lr.x), BFLO(lr.y), BFHI(lr.y)}, k_ = {BFLO(lk.x), BFHI(lk.x), BFLO(lk.y), BFHI(lk.y)}, v_ = {BFLO(lv.x), BFHI(lv.x), BFLO(lv.y), BFHI(lv.y)}; \
        const f32x4 kk_ = {BFLO(lkk.x), BFHI(lkk.x), BFLO(lkk.y), BFHI(lkk.y)}, e_ = {BFLO(le.x), BFHI(le.x), BFLO(le.y), BFHI(le.y)}, i_ = {BFLO(li.x), BFHI(li.x), BFLO(li.y), BFHI(li.y)}; \
        const f32x4 kav_ = {ka[0], ka[1], ka[2], ka[3]}; \
        *(f32x4*)(bb_ + 0 * 2048) = 1.f - e_; *(f32x4*)(bb_ + 1 * 2048) = -kk_; *(f32x4*)(bb_ + 2 * 2048) = kk_ * i_; \
        *(f32x4*)(bb_ + 3 * 2048) = k_ * ((i_ - 1.f) * kav_ + 1.f); *(f32x4*)(bb_ + 4 * 2048) = r_; *(f32x4*)(bb_ + 5 * 2048) = v_; } while (0)
    SCAN_LOAD(0); SCAN_STORE(0);
    __syncthreads();
    float S[4] = {0.f, 0.f, 0.f, 0.f};
    for (int c = 0; c < NCH; ++c) {
        if (c + 1 < NCH) SCAN_LOAD(c + 1);
        { const float* bb = bufs + (c & 1) * 12288 + 4 * g; float* ys = yst + (c & 1) * 1024 + rowl; const float* vb = bufs + (c & 1) * 12288 + 5 * 2048 + half * 32 + rowl;
          f32x4 w4[3], a4[3], b4[3], k4[3], r4[3]; float vv[3];
#define LDOPS(s_) do { const float* p_ = bb + (s_) * 64; w4[(s_) % 3] = *(const f32x4*)(p_); a4[(s_) % 3] = *(const f32x4*)(p_ + 2048); b4[(s_) % 3] = *(const f32x4*)(p_ + 4096); k4[(s_) % 3] = *(const f32x4*)(p_ + 6144); \
              r4[(s_) % 3] = *(const f32x4*)(p_ + 8192); vv[(s_) % 3] = vb[(s_) * 64]; } while (0)
          LDOPS(0); LDOPS(1);
#pragma unroll
          for (int s = 0; s < TS; ++s) {
              const f32x4 a_ = a4[s % 3], w_ = w4[s % 3], b_ = b4[s % 3], k_ = k4[s % 3], r_ = r4[s % 3];
              const float av[4] = {a_.x, a_.y, a_.z, a_.w}, wv[4] = {w_.x, w_.y, w_.z, w_.w}, bv[4] = {b_.x, b_.y, b_.z, b_.w}, kv[4] = {k_.x, k_.y, k_.z, k_.w}, rv[4] = {r_.x, r_.y, r_.z, r_.w};
              const float v1 = vv[s % 3];
              if (s + 2 < TS) LDOPS(s + 2);
              float t = S[0] * av[0]; t = fmaf(S[1], av[1], t); t = fmaf(S[2], av[2], t); t = fmaf(S[3], av[3], t);
              t += dppf<0xB1>(t); t += dppf<0x4E>(t); t += dppf<0x141>(t); t += dppf<0x140>(t);
#pragma unroll
              for (int q = 0; q < 4; ++q) S[q] = fmaf(S[q], wv[q], fmaf(bv[q], t, kv[q] * v1));
              float u = S[0] * rv[0]; u = fmaf(S[1], rv[1], u); u = fmaf(S[2], rv[2], u); u = fmaf(S[3], rv[3], u);
              u += dppf<0xB1>(u); u += dppf<0x4E>(u); u += dppf<0x141>(u); u += dppf<0x140>(u);
              ys[s * 32] = u;
          }
#undef LDOPS
        }
        if (c + 1 < NCH) SCAN_STORE(c + 1);
        __syncthreads();
        { const f32x2 yv = *(const f32x2*)(yst + (c & 1) * 1024 + ss * 32 + 2 * part); const int row_ = SCAN_ROW(c * TS + ss);
          *(unsigned*)(Y + (size_t)row_ * 1024 + h * 64 + half * 32 + 2 * part) = pk2(yv.x, yv.y); }
    }
    __syncthreads();
#undef SCAN_ROW
#undef SCAN_LOAD
#undef SCAN_STORE
#undef BFLO
#undef BFHI
}

constexpr int AT_K = 0, AT_V = 16384, AT_WS = 32768, AT_OST = 34816, AT_RPB = 67584, AT_Q = 90112;
struct NaInfo { int i0, R0, nW; size_t latbase, ctxbase; };
template <int MODE> __device__ __forceinline__ void attn_unit(unsigned char* shmu, const bf16_t* Qw, int qpitch, const bf16_t* Kb, const bf16_t* Vb, int kvpitch, int ntiles,
                                                              bf16_t* Ow, int opitch, const NaInfo na) {
    using namespace att;
    char* shm = (char*)shmu;
    const int tid = tidx(), lane = tid & 63, r32 = lane & 31, hi = lane >> 5; const int wid = __builtin_amdgcn_readfirstlane(tid >> 6);
    bf16x8 qr[4];
#pragma unroll
    for (int d0 = 0; d0 < 4; ++d0) qr[d0] = *reinterpret_cast<const bf16x8*>(Qw + (size_t)r32 * qpitch + d0 * 16 + hi * 8);
    float* wsf = (float*)(shm + AT_WS) + wid * 64;
    const float* rpbs = (const float*)(shm + AT_RPB);
    const unsigned lds0 = (unsigned)(uintptr_t)shm;
    const int vb0 = (int)(lds0 + AT_V) + ((lane >> 4) & 1) * 32 + (lane & 3) * 8 + (4 * hi + ((lane & 15) >> 2)) * 64;
    const int kkey = lane, kch = wid;
    const int vkey = 16 * (wid & 3) + (lane >> 2), vd = (wid >> 2) * 32 + (lane & 3) * 8;
    const int sdst = wid * 1024 + lane * 16;
#define AT_ROWOFF(t) (MODE == 0 ? (size_t)(t) * 64 : ((t) < na.nW ? na.latbase + (size_t)(na.R0 + (t)) * 64 : na.ctxbase + (size_t)((t) - na.nW) * 64))
    u32x4 kreg, vreg;
    { const size_t ro = AT_ROWOFF(0); kreg = *(const u32x4*)(Kb + (ro + kkey) * kvpitch + kch * 8); vreg = *(const u32x4*)(Vb + (ro + vkey) * kvpitch + vd); }
    *(u32x4*)(shm + AT_K + sdst) = kreg; *(u32x4*)(shm + AT_V + sdst) = vreg;
    __syncthreads();
    float m_run = -1e30f, l_run = 0.f; f32x16 o[2]; o[0] = f32x16{}; o[1] = f32x16{};
    const f32x16 zero16 = f32x16{};
    const int qi = na.i0 + (wid >> 1), qc = 32 * (wid & 1) + r32; const int rs = min(max(qi - 4, 0), 56), csn = min(max(qc - 8, 0), 48);
    for (int t = 0; t < ntiles; ++t) {
        if (t + 1 < ntiles) { const size_t ro = AT_ROWOFF(t + 1); kreg = *(const u32x4*)(Kb + (ro + kkey) * kvpitch + kch * 8); vreg = *(const u32x4*)(Vb + (ro + vkey) * kvpitch + vd); }
        bool rel = true; int krow = 0;
        if (MODE == 1 && t < na.nW) { krow = na.R0 + t; rel = (krow >= rs) && (krow <= rs + 7); }
        if (rel) {
            f32x16 p0, p1;
            qkt(p0, p1, shm + AT_K + (t & 1) * 8192, qr, zero16, r32, hi);
            if (MODE == 1 && t < na.nW) { const int dr = (krow - qi + 7) * 31 + 15 - qc;
#pragma unroll
                for (int r = 0; r < 16; ++r) { const int kc0 = crow(r, hi), kc1 = kc0 + 32;
                    const bool v0 = (kc0 >= csn) && (kc0 < csn + 16), v1 = (kc1 >= csn) && (kc1 < csn + 16);
                    const float b0 = rpbs[v0 ? dr + kc0 : 0], b1 = rpbs[v1 ? dr + kc1 : 0];
                    p0[r] = v0 ? p0[r] + b0 : -1e30f; p1[r] = v1 ? p1[r] + b1 : -1e30f; } }
            const float rm = rowmax(p0, p1);
            const float m_new = fmaxf(m_run, rm); const float alpha = __builtin_amdgcn_exp2f(m_run - m_new); m_run = m_new;
            float sacc = 0.f;
#pragma unroll
            for (int r = 0; r < 16; ++r) { p0[r] = __builtin_amdgcn_exp2f(p0[r] - m_new); p1[r] = __builtin_amdgcn_exp2f(p1[r] - m_new); sacc += p0[r] + p1[r]; }
            l_run = l_run * alpha + sacc;
            if (hi == 0) wsf[r32] = alpha;
            asm volatile("s_waitcnt lgkmcnt(0)" ::: "memory");
#pragma unroll
            for (int r = 0; r < 16; ++r) { const float f = wsf[crow(r, hi)]; o[0][r] *= f; o[1][r] *= f; }
            u32x4 pw0, pw1, pw2, pw3;
            pw0 = (u32x4){cvtpk_s(p0[0], p0[1]), cvtpk_s(p0[2], p0[3]), cvtpk_s(p0[4], p0[5]), cvtpk_s(p0[6], p0[7])};
            pw1 = (u32x4){cvtpk_s(p0[8], p0[9]), cvtpk_s(p0[10], p0[11]), cvtpk_s(p0[12], p0[13]), cvtpk_s(p0[14], p0[15])};
            pw2 = (u32x4){cvtpk_s(p1[0], p1[1]), cvtpk_s(p1[2], p1[3]), cvtpk_s(p1[4], p1[5]), cvtpk_s(p1[6], p1[7])};
            pw3 = (u32x4){cvtpk_s(p1[8], p1[9]), cvtpk_s(p1[10], p1[11]), cvtpk_s(p1[12], p1[13]), cvtpk_s(p1[14], p1[15])};
            pv(o, vb0 + (t & 1) * 8192, __builtin_bit_cast(bf16x8, pw0), __builtin_bit_cast(bf16x8, pw1), __builtin_bit_cast(bf16x8, pw2), __builtin_bit_cast(bf16x8, pw3));
        }
        if (t + 1 < ntiles) { *(u32x4*)(shm + AT_K + ((t + 1) & 1) * 8192 + sdst) = kreg; *(u32x4*)(shm + AT_V + ((t + 1) & 1) * 8192 + sdst) = vreg; }
        __syncthreads();
    }
    { auto rr = __builtin_amdgcn_permlane32_swap(__float_as_uint(l_run), __float_as_uint(l_run), false, false); l_run = __uint_as_float(rr[0]) + __uint_as_float(rr[1]); }
    if (hi == 0) wsf[32 + r32] = l_run;
    asm volatile("s_waitcnt lgkmcnt(0)" ::: "memory");
    float rli[16];
#pragma unroll
    for (int r = 0; r < 16; ++r) rli[r] = __builtin_amdgcn_rcpf(wsf[32 + crow(r, hi)]);
    { bf16_t* stg = (bf16_t*)(shm + AT_OST) + wid * 2048;
#pragma unroll
      for (int r = 0; r < 16; ++r) { const int orow = crow(r, hi);
#pragma unroll
          for (int d0 = 0; d0 < 2; ++d0) stg[orow * 64 + d0 * 32 + r32] = (bf16_t)f2bf(o[d0][r] * rli[r]); }
      asm volatile("s_waitcnt lgkmcnt(0)" ::: "memory");
#pragma unroll
      for (int i = 0; i < 4; ++i) { const int row = i * 8 + (lane >> 3), ch = lane & 7; const u32x4 v = *(const u32x4*)(stg + row * 64 + ch * 8); *(u32x4*)(Ow + (size_t)row * opitch + ch * 8) = v; } }
    __syncthreads();
#undef AT_ROWOFF
}

__device__ __forceinline__ void phase_mix0(unsigned char* shm, int ctrw) {
#ifndef SCANREP
#define SCANREP 1
#endif
    for (int srep = 0; srep < SCANREP; ++srep)
    for (int hs = blockIdx.x; hs < 256; hs += gridDim.x) { const int x8 = hs & 7, slot = hs >> 3; scan_block(shm, (x8 >> 2) * 64 + (x8 & 3) * 16 + (slot >> 1), slot & 1); }
#ifndef QREP
#define QREP 1
#endif
    for (int qrep = 0; qrep < QREP; ++qrep) {
    unsigned* ctr = (unsigned*)(kws() + WS_CTL) + ctrw + 16 * qrep;
    const bf16_t* Q0 = (const bf16_t*)((unsigned char*)kout() + DO_Q0); const bf16_t* KALL = (const bf16_t*)(kws() + WS_KALL); const bf16_t* VALL = (const bf16_t*)(kws() + WS_VALL);
    bf16_t* OC = (bf16_t*)(kws() + WS_H);
    const int wid = tidx() >> 6; const NaInfo na{0, 0, 0, 0, 0};
    for (;;) {
        if (tidx() == 0) *(volatile unsigned*)(shm + AT_Q) = atomicAdd(ctr, 1u);
        __syncthreads();
        const unsigned u = *(volatile unsigned*)(shm + AT_Q);
        __syncthreads();
        if (u >= 1088u + (unsigned)(TQ_ITEMS / 64)) break;
        if (u >= 1088u) { const int base = (int)(u - 1088u) * 64; float* scr = (float*)(shm + wid * 8448); const int lane = tidx() & 63;
            for (int e = 0; e < 8; ++e) transpose_deferred(base + e * 8 + wid, scr, lane);
            __syncthreads(); continue; }
        if (u < 1024u) { const int b = u >> 8, hq = (u >> 4) & 15, qb = u & 15, kvh = hq >> 2; const size_t qrow = (size_t)b * SEQ + qb * 256 + wid * 32;
            att::attn_unit_p<8>((const att::bf16*)(Q0 + (qrow - wid * 32) * 1024 + hq * 64), 1024, (const att::bf16*)(KALL + (size_t)(b * 4 + kvh) * KVLEN * 64), (const att::bf16*)(VALL + (size_t)(b * 4 + kvh) * KVLEN * 64), 64, KVLEN / 64, (att::bf16*)(OC + (qrow - wid * 32) * 2048 + hq * 64), 2048, (char*)shm); }
        else { const int cu = u - 1024, b = cu >> 4, hq = cu & 15, kvh = hq >> 2; const size_t qrow = (size_t)NLAT + b * CTX + wid * 32;
            att::attn_unit_p<8>((const att::bf16*)(Q0 + (qrow - wid * 32) * 1024 + hq * 64), 1024, (const att::bf16*)(KALL + ((size_t)(b * 4 + kvh) * KVLEN + SEQ) * 64), (const att::bf16*)(VALL + ((size_t)(b * 4 + kvh) * KVLEN + SEQ) * 64), 64, CTX / 64, (att::bf16*)(OC + (qrow - wid * 32) * 2048 + hq * 64), 2048, (char*)shm); }
    }
    }
}
__device__ __forceinline__ void phase_mix1(unsigned char* shm) {
    const bf16_t* Q1 = (const bf16_t*)(kws() + WS_Q1); const bf16_t* K1 = (const bf16_t*)(kws() + WS_K1); const bf16_t* V1 = (const bf16_t*)(kws() + WS_V1); bf16_t* O1 = (bf16_t*)(kws() + WS_O1);
    const float* rpb = kin(34);
    float* rp = (float*)(shm + 86016);
    const bool fixed_head = gridDim.x == 256; int h_loaded = -1;
    for (int k = 0, u = blockIdx.x; u < 2048; ++k, u += gridDim.x) {
        int rb, h, b;
        if (fixed_head) { h = blockIdx.x & 31; const int rest = (blockIdx.x >> 5) + 8 * k; b = rest >> 4; rb = rest & 15; } else { rb = u & 15; h = (u >> 4) & 31; b = u >> 9; }
        const int i0 = rb * 4;
        if (h != h_loaded) { __syncthreads(); for (int i = tidx(); i < 465; i += 512) rp[i] = rpb[h * 465 + i] * LOG2E; h_loaded = h; }
        __syncthreads();
        att::NaP na; na.i0 = i0; na.R0 = min(max(i0 - 4, 0), 56); const int R1 = min(max(i0 + 3 - 4, 0), 56) + 7; na.nW = R1 - na.R0 + 1; na.rpbs = rp;
        const size_t latrow0 = (size_t)b * SEQ + (size_t)na.R0 * 64, ctxrow0 = (size_t)NLAT + b * CTX;
        na.jump = (long)ctxrow0 - (long)(latrow0 + (size_t)na.nW * 64);
        const int NTt = (na.nW + 4 + 1) & ~1;
        const size_t qrow = (size_t)b * SEQ + (size_t)i0 * 64;
        att::attn_unit_na<8>((const att::bf16*)(Q1 + qrow * 2048 + h * 64), 2048, (const att::bf16*)(K1 + latrow0 * 2048 + h * 64), (const att::bf16*)(V1 + latrow0 * 2048 + h * 64), 2048, NTt,
                             (att::bf16*)(O1 + qrow * 2048 + h * 64), 2048, (char*)shm, na);
        __syncthreads();
    }
}
__device__ __forceinline__ int opq(int v) { asm volatile("" : "+s"(v)); return v; }
#ifdef SYNC2
#define GSYNC() do { xcd_barrier(xbar); xcd_barrier(xbar); } while (0)
#else
#define GSYNC() xcd_barrier(xbar)
#endif
#ifndef DUPMASK
#define DUPMASK 0u
#endif
#define REP(k) for (int rep_ = 0; rep_ < 1 + (int)((DUPMASK >> (k)) & 1u); ++rep_)
__global__ void __launch_bounds__(512, 2) fwd_megakernel(Args a) {
    extern __shared__ __attribute__((aligned(16))) unsigned char lds[];
    cg::grid_group grid = cg::this_grid();
    { volatile LAS unsigned* st0 = (volatile LAS unsigned*)((LAS unsigned char*)lds + (LDS_BYTES - 64)); if (tidx() == 0) { st0[0] = 0u; st0[1] = 0u; } }
    __syncthreads();
    const XcdBarrier xbar = xcd_barrier_post((unsigned*)(kws() + WS_CTL) + 4096, (volatile LAS unsigned*)((LAS unsigned char*)lds + (LDS_BYTES - 64)));
#define G opq(gridDim.x)
#define c opq(blockIdx.x)
#define ws kws()
#define XIN kin(0)
#define CIN kin(2)
#define mod ((float*)(kws() + WS_MOD))
#define ctxr ((float*)(kws() + WS_CTXR))
#define H ((bf16_t*)(kws() + WS_H))
#define mod1 (mod + 5 * 12288)
    PG8_LAS unsigned char* glds = (PG8_LAS unsigned char*)lds;
    if (gridDim.y == 0x7fffu) grid.sync();
    REP(0) { phase_prologue(lds);
    GSYNC(); }
    REP(5) { phase_norm_mod(XIN, CIN, kin(4), mod + 0, mod + 2048, H, NT);
    GSYNC(); }
    { pg8::Gemm g{H, (const bf16_t*)(ws + WS_WIN), NT, INP, DM, DM}; pg8::StaticOrder S; S.init(NT, INP, G, c);
      pg8::EpiBf16<0> E{(bf16_t*)(ws + WS_P), INP, 0, 0, 1.f, nullptr};
      pg8::gemm_phase<pg8::EpiBf16<0>, pg8::StaticOrder, true, true>(glds, g, S, E); }
    GSYNC();
    REP(1) { phase_prep0();
    GSYNC(); }
    { pg8::Gemm g{(const bf16_t*)(ws + WS_AP), (const bf16_t*)(ws + WS_BP), NT, INP, 512, 256}; pg8::SliceOrder S; S.init(NT, INP, G, c); S.pn1 = 16;
      pg8::EpiBf16<3> E{(bf16_t*)(ws + WS_P), INP, 0, 0, 1.f, (const float*)(kws() + WS_ZB)};
      pg8::gemm_phase<pg8::EpiBf16<3>, pg8::SliceOrder, true, true>(glds, g, S, E); }
    GSYNC();
    REP(2) { phase_mix0(lds, 64 + 64 * rep_);
    GSYNC(); }
    REP(3) { phase_finish0();
    GSYNC(); }
    { pg8::Gemm g{H, (const bf16_t*)(ws + WS_WO0), NT, DM, DM, DM}; pg8::StaticOrder S; S.init(NT, DM, G, c);
      pg8::EpiResidB<false> E{XIN, (bf16_t*)(ws + WS_XRB), CIN, (bf16_t*)(ws + WS_XRB), ctxr, mod + 4096};
      pg8::gemm_phase<pg8::EpiResidB<false>, pg8::StaticOrder, true, true>(glds, g, S, E); }
    GSYNC();
    phase_norm_mod(kout(), ctxr, kin(5), mod + 6144, mod + 8192, H, NT, nullptr, nullptr, (bf16_t*)(ws + WS_XRB));
    GSYNC();
    REP(6)
    { pg8::Gemm g{H, (const bf16_t*)(ws + WS_W10), NT, 8192, DM, DM}; pg8::StaticOrder S; S.init(NT, 8192, G, c);
      pg8::EpiBf16<2> E{(bf16_t*)(ws + WS_U), 8192, 0, 0, 1.f, nullptr};
      pg8::gemm_phase<pg8::EpiBf16<2>, pg8::StaticOrder, true, true>(glds, g, S, E); }
    GSYNC();
    { pg8::Gemm g{(const bf16_t*)(ws + WS_U), (const bf16_t*)(ws + WS_W20), NLAT, DM, 8192, 8192}; pg8::StaticOrder S; S.init(NLAT, DM, G, c);
      pg8::EpiResidB<true> E{XIN, (bf16_t*)(ws + WS_XRB), ctxr, (bf16_t*)(ws + WS_XRB), ctxr, mod + 10240};
      pg8::gemm_phase<pg8::EpiResidB<true>, pg8::StaticOrder, true, true>(glds, g, S, E); }
    { pg8::Gemm g{(const bf16_t*)(ws + WS_U) + (size_t)NLAT * 8192, (const bf16_t*)(ws + WS_W20), NCTX, DM, 8192, 1024}; pg8::SplitOrder S; S.init(NCTX, DM, 8, G, c);
      pg8::EpiPartial E{(float*)(ws + WS_PART)};
      pg8::gemm_phase<pg8::EpiPartial, pg8::SplitOrder, true, true>(glds, g, S, E); }
    GSYNC();
    phase_norm_mod(kout(), ctxr, kin(29), mod1 + 0, mod1 + 2048, H, NT, (const float*)(ws + WS_PART), mod + 10240, (bf16_t*)(ws + WS_XRB));
    GSYNC();
    { pg8::Gemm g{H, (const bf16_t*)(ws + WS_WQKV), NT, 6144, DM, DM}; pg8::StaticOrder S; S.init(NT, 6144, G, c);
      pg8::EpiBf16<0> E{(bf16_t*)(ws + WS_Q1), 2048, 2048, (size_t)(WS_K1 - WS_Q1) / 2, 0.125f * LOG2E, nullptr};
      pg8::gemm_phase<pg8::EpiBf16<0>, pg8::StaticOrder, true, true>(glds, g, S, E); }
    GSYNC();
    REP(4) { phase_mix1(lds);
    GSYNC(); }
    { pg8::Gemm g{(const bf16_t*)(ws + WS_O1), (const bf16_t*)(ws + WS_WO1), NLAT, DM, DM, DM}; pg8::StaticOrder S; S.init(NLAT, DM, G, c);
      pg8::EpiResidB<true> E{XIN, (bf16_t*)(ws + WS_XRB), ctxr, (bf16_t*)(ws + WS_XRB), ctxr, mod1 + 4096};
      pg8::gemm_phase<pg8::EpiResidB<true>, pg8::StaticOrder, true, true>(glds, g, S, E); }
    GSYNC();
    phase_norm_mod(kout(), ctxr, kin(30), mod1 + 6144, mod1 + 8192, H, NLAT, nullptr, nullptr, (bf16_t*)(ws + WS_XRB));
    GSYNC();
    { pg8::Gemm g{H, (const bf16_t*)(ws + WS_W11), NLAT, 8192, DM, DM}; pg8::StaticOrder S; S.init(NLAT, 8192, G, c);
      pg8::EpiBf16<2> E{(bf16_t*)(ws + WS_U), 8192, 0, 0, 1.f, nullptr};
      pg8::gemm_phase<pg8::EpiBf16<2>, pg8::StaticOrder, true, true>(glds, g, S, E); }
    GSYNC();
    { pg8::Gemm g{(const bf16_t*)(ws + WS_U), (const bf16_t*)(ws + WS_W21), NLAT, DM, 8192, 8192}; pg8::StaticOrder S; S.init(NLAT, DM, G, c);
      pg8::EpiResidB<true> E{XIN, (bf16_t*)(ws + WS_XRB), ctxr, (bf16_t*)(ws + WS_XRB), ctxr, mod1 + 10240};
      pg8::gemm_phase<pg8::EpiResidB<true>, pg8::StaticOrder, true, true>(glds, g, S, E); }
    GSYNC();
    phase_final_norm(kout(), kin(38), NLAT, (bf16_t*)(ws + WS_XRB));
#undef G
#undef c
#undef ws
#undef XIN
#undef CIN
#undef mod
#undef ctxr
#undef H
#undef mod1
}

extern "C" void kernel_launch(void* const* d_in, const int* in_sizes, int n_in, void* d_out, int out_size, void* d_ws, size_t ws_size, hipStream_t stream) {
    static int grid = 0;
    if (grid == 0) {
        if (n_in != 39 || out_size != NLAT * DM || ws_size < WS_END) { fprintf(stderr, "kernel_launch: unexpected shapes (n_in %d out %d ws %zu)\n", n_in, out_size, ws_size); grid = -1; return; }
        int dev = 0, cus = 0, per = 0;
        (void)hipGetDevice(&dev); (void)hipDeviceGetAttribute(&cus, hipDeviceAttributeMultiprocessorCount, dev);
        (void)hipFuncSetAttribute((const void*)fwd_megakernel, hipFuncAttributeMaxDynamicSharedMemorySize, LDS_BYTES);
        (void)hipOccupancyMaxActiveBlocksPerMultiprocessor(&per, (const void*)fwd_megakernel, 512, LDS_BYTES);
        if (per < 1) per = 1;
        grid = cus * per;
        fprintf(stderr, "kernel_launch: grid %d (cus %d x %d), ws %zu\n", grid, cus, per, ws_size);
    }
    if (grid < 0) return;
    (void)hipMemsetAsync((char*)d_ws + WS_CTL, 0, 65536, stream);
    Args a{};
    for (int i = 0; i < 39; ++i) a.in[i] = (const float*)d_in[i];
    a.out = (float*)d_out; a.ws = (unsigned char*)d_ws; a.grid = grid; a.pad = 0;
    void* args[] = {&a};
    hipError_t e = hipLaunchCooperativeKernel((const void*)fwd_megakernel, dim3(grid), dim3(512), args, LDS_BYTES, stream);
    if (e != hipSuccess) fprintf(stderr, "kernel_launch: cooperative launch failed: %s (grid %d)\n", hipGetErrorString(e), grid);
}
```

```cpp
#include <hip/hip_runtime.h>
#include <hip/hip_bf16.h>
#include <hip/hip_cooperative_groups.h>
#include <cstdio>
#include <cstdint>
#include <cmath>
namespace cg = cooperative_groups;
namespace pg8 {
#define PG8_LAS __attribute__((address_space(3)))
typedef unsigned short bf16_t;
typedef short bf16x8 __attribute__((ext_vector_type(8)));
typedef float f32x4 __attribute__((ext_vector_type(4)));
typedef unsigned u32x4 __attribute__((ext_vector_type(4)));
constexpr int BM = 256, BK = 64, HALF = 128, HTB = HALF * BK * 2  , STAGE_BYTES = 8 * HTB, NXCD = 8, WGM = 8;

__host__ __device__ __forceinline__ int lds_byte(int r, int c) { const int st = (r >> 4) * 2 + (c >> 5), rr = r & 15, cc = c & 31, ob = rr * 64 + cc * 2; return st * 1024 + (ob ^ (((ob >> 9) & 1) << 5)); }
__host__ __device__ __forceinline__ void stage_rc(int b, int& R, int& C) { const int st = b / 1024, sb = b % 1024, swz = sb ^ (((sb >> 9) & 1) << 5); R = (st >> 1) * 16 + swz / 64; C = (st & 1) * 32 + (swz % 64) / 2; }
__host__ __device__ __forceinline__ int perm32(int rho) { const int n = rho >> 4, i = rho & 15; return 8 * (i >> 2) + 4 * n + (i & 3); }

struct Unit { int pm, pn, ks; };
struct Gemm { const bf16_t* A; const bf16_t* Bt; int M, N, K, Kc; };

struct StaticOrder {
    int nM, nN, nwg, G, c;
    __host__ __device__ void init(int M, int N, int G_, int c_) { nM = M / BM; nN = N / BM; nwg = nM * nN; G = G_; c = c_; }
    __host__ __device__ bool next(int i, Unit& u) const {
        const long L = (long)i * G + c; if (L >= nwg) return false;
        int wgid = (int)L; { const int q = nwg / NXCD, r = nwg % NXCD, xcd = wgid % NXCD, off = wgid / NXCD; wgid = (xcd < r ? xcd * (q + 1) : r * (q + 1) + (xcd - r) * q) + off; }
        const int nig = WGM * nN, gid = wgid / nig, fm = gid * WGM, gsz = (nM - fm) < WGM ? (nM - fm) : WGM;
        u.pm = fm + ((wgid % nig) % gsz); u.pn = (wgid % nig) / gsz; u.ks = 0; return true;
    }
    __device__ __forceinline__ void a_ready(const Unit&) const {}
    __device__ __forceinline__ void done(const Unit&) const {}
};

struct SplitOrder {
    int nM, nN, ksplit, total, G, c;
    __host__ __device__ void init(int M, int N, int ksplit_, int G_, int c_) { nM = M / BM; nN = N / BM; ksplit = ksplit_; total = nM * nN * ksplit; G = G_; c = c_; }
    __host__ __device__ bool next(int i, Unit& u) const { const long L = (long)i * G + c; if (L >= total) return false; const int t = (int)(L / ksplit); u.ks = (int)(L % ksplit); u.pn = t % nN; u.pm = t / nN; return true; }
    __device__ __forceinline__ void a_ready(const Unit&) const {}
    __device__ __forceinline__ void done(const Unit&) const {}
};
struct SliceOrder : StaticOrder {
    int pn1;
    __host__ __device__ bool next(int i, Unit& u) const { if (!StaticOrder::next(i, u)) return false; u.ks = u.pn >= pn1 ? 1 : 0; return true; }
};
__device__ __forceinline__ unsigned cvt_pk_bf16(float lo, float hi) { unsigned r; asm volatile("v_cvt_pk_bf16_f32 %0, %1, %2" : "=v"(r) : "v"(lo), "v"(hi)); return r; }
typedef float f32x2 __attribute__((ext_vector_type(2)));
template <int ACT> struct EpiBf16 {
    static constexpr bool PERM = true, AFTER_DRAIN = false;
    bf16_t* O; int ldc; int split_cols; size_t split_stride; float scale0; const float* zb;
    __device__ __forceinline__ void operator()(const f32x4 (&acc)[2][2][4][2], const Unit& u, int wr, int wc, int fr, int fq) const {
        const int row0 = u.pm * BM + wr * 64 + fr; int colt = u.pn * BM; bf16_t* base = O;
        float sc = 1.f; if (split_cols) { const int t = colt / split_cols; base += (size_t)t * split_stride; colt -= t * split_cols; if (t == 0) sc = scale0; }
        const int col0 = colt + wc * 32 + 8 * fq;
        int blk = 0; int cb = 0;
        if (ACT == 3) { blk = u.pn >> 2; cb = u.pn * BM + wc * 32 + 8 * fq; }
#pragma unroll
        for (int ai = 0; ai < 2; ++ai)
#pragma unroll
            for (int m = 0; m < 4; ++m) { bf16_t* rowp = base + (size_t)(row0 + ai * HALF + m * 16) * ldc + col0;
#pragma unroll
                for (int bj = 0; bj < 2; ++bj) { f32x4 v0 = acc[ai][bj][m][0], v1 = acc[ai][bj][m][1];
                    if (ACT == 2) {
#pragma unroll
                        for (int e = 0; e < 4; ++e) { float a = fmaxf(v0[e], 0.f), b = fmaxf(v1[e], 0.f); v0[e] = a * a; v1[e] = b * b; } }
                    if (ACT == 3) {
                        v0 = v0 + *(const f32x4*)(zb + cb + bj * HALF); v1 = v1 + *(const f32x4*)(zb + cb + bj * HALF + 4);
                        if (blk < 4) {
#pragma unroll
                            for (int e = 0; e < 4; ++e) { float s0 = 1.f / (1.f + __expf(-v0[e])), s1 = 1.f / (1.f + __expf(-v1[e]));
                                if (blk < 2) { s0 = 1.f - __expf(-0.60653066f * s0); s1 = 1.f - __expf(-0.60653066f * s1); }
                                v0[e] = s0; v1[e] = s1; } } }
                    v0 = v0 * sc; v1 = v1 * sc; u32x4 w; w.x = cvt_pk_bf16(v0[0], v0[1]); w.y = cvt_pk_bf16(v0[2], v0[3]); w.z = cvt_pk_bf16(v1[0], v1[1]); w.w = cvt_pk_bf16(v1[2], v1[3]);
                    *(u32x4*)(rowp + bj * HALF) = w; } }
    }
};
struct EpiResid {
    static constexpr bool PERM = false, AFTER_DRAIN = false;
    const float* baseL; const float* baseC; float* outL; float* outC; const float* gate;
    __device__ __forceinline__ void operator()(const f32x4 (&acc)[2][2][4][2], const Unit& u, int wr, int wc, int fr, int fq) const {
        const int trow = u.pm * BM; const bool isc = trow >= 16384; const int ridx = isc ? 4 : (trow >> 12);
        const float* g = gate + (size_t)ridx * 12288; const float* base = isc ? baseC : baseL; float* out = isc ? outC : outL;
        const int row0 = (isc ? trow - 16384 : trow) + wr * 64 + fr; const int col0 = u.pn * BM + wc * 32 + 4 * fq;
#pragma unroll
        for (int bj = 0; bj < 2; ++bj)
#pragma unroll
            for (int n = 0; n < 2; ++n) { const f32x4 gv = *(const f32x4*)(g + col0 + bj * HALF + n * 16);
#pragma unroll
                for (int ai = 0; ai < 2; ++ai)
#pragma unroll
                    for (int m = 0; m < 4; ++m) { const size_t off = (size_t)(row0 + ai * HALF + m * 16) * 2048 + col0 + bj * HALF + n * 16;
                        const f32x4 bs = *(const f32x4*)(base + off); *(f32x4*)(out + off) = bs + gv * acc[ai][bj][m][n]; } }
    }
};
struct EpiPartial {
    static constexpr bool PERM = true, AFTER_DRAIN = false;
    float* part;
    __device__ __forceinline__ void operator()(const f32x4 (&acc)[2][2][4][2], const Unit& u, int wr, int wc, int fr, int fq) const {
        float* out = part + (size_t)u.ks * (1024 * 2048); const int row0 = u.pm * BM + wr * 64 + fr; const int col0 = u.pn * BM + wc * 32 + 8 * fq;
#pragma unroll
        for (int bj = 0; bj < 2; ++bj)
#pragma unroll
            for (int ai = 0; ai < 2; ++ai)
#pragma unroll
                for (int m = 0; m < 4; ++m) { float* o = out + (size_t)(row0 + ai * HALF + m * 16) * 2048 + col0 + bj * HALF; *(f32x4*)(o) = acc[ai][bj][m][0]; *(f32x4*)(o + 4) = acc[ai][bj][m][1]; }
    }
};
template <bool BASE_BF16> struct EpiResidB {
    static constexpr bool PERM = true, AFTER_DRAIN = false;
    const float* baseLf; const bf16_t* baseLb; const float* baseC; bf16_t* outLb; float* outC; const float* gate;
    __device__ __forceinline__ void operator()(const f32x4 (&acc)[2][2][4][2], const Unit& u, int wr, int wc, int fr, int fq) const {
        const int trow = u.pm * BM; const bool isc = trow >= 16384; const int ridx = isc ? 4 : (trow >> 12);
        const float* g = gate + (size_t)ridx * 12288; const int row0 = (isc ? trow - 16384 : trow) + wr * 64 + fr; const int col0 = u.pn * BM + wc * 32 + 8 * fq;
#pragma unroll
        for (int bj = 0; bj < 2; ++bj) { const f32x4 g0 = *(const f32x4*)(g + col0 + bj * HALF), g1 = *(const f32x4*)(g + col0 + bj * HALF + 4);
#pragma unroll
            for (int ai = 0; ai < 2; ++ai)
#pragma unroll
                for (int m = 0; m < 4; ++m) { const size_t off = (size_t)(row0 + ai * HALF + m * 16) * 2048 + col0 + bj * HALF;
                    if (isc) { *(f32x4*)(outC + off) = *(const f32x4*)(baseC + off) + g0 * acc[ai][bj][m][0]; *(f32x4*)(outC + off + 4) = *(const f32x4*)(baseC + off + 4) + g1 * acc[ai][bj][m][1]; }
                    else { f32x4 b0, b1;
                        if (BASE_BF16) { const u32x4 w = *(const u32x4*)(baseLb + off);
                            b0 = (f32x4){__uint_as_float(w.x << 16), __uint_as_float(w.x & 0xffff0000u), __uint_as_float(w.y << 16), __uint_as_float(w.y & 0xffff0000u)};
                            b1 = (f32x4){__uint_as_float(w.z << 16), __uint_as_float(w.z & 0xffff0000u), __uint_as_float(w.w << 16), __uint_as_float(w.w & 0xffff0000u)}; }
                        else { b0 = *(const f32x4*)(baseLf + off); b1 = *(const f32x4*)(baseLf + off + 4); }
                        const f32x4 o0 = b0 + g0 * acc[ai][bj][m][0], o1 = b1 + g1 * acc[ai][bj][m][1];
                        u32x4 w; w.x = cvt_pk_bf16(o0[0], o0[1]); w.y = cvt_pk_bf16(o0[2], o0[3]); w.z = cvt_pk_bf16(o1[0], o1[1]); w.w = cvt_pk_bf16(o1[2], o1[3]);
                        *(u32x4*)(outLb + off) = w; } } }
    }
};
template <class Epi, class Sched, bool ALIGN_EPI = false, bool SP2 = false>
__device__ __forceinline__ void gemm_phase(PG8_LAS unsigned char* lds, const Gemm g, const Sched& S, const Epi& E) {
    int tid_ = threadIdx.x; asm volatile("" : "+v"(tid_)); const int tid = tid_, wid = __builtin_amdgcn_readfirstlane(tid >> 6), lane = tid & 63, wr = wid >> 2, wc = wid & 3, fr = lane & 15, fq = lane >> 4;
    const int K = g.K, nt = g.Kc / BK; const size_t kcb = (size_t)g.Kc * 2;
    unsigned voffA[2], voffB[2];
#pragma unroll
    for (int i = 0; i < 2; ++i) { int R, C; stage_rc(tid * 16 + i * 8192, R, C); const int Rb = Epi::PERM ? ((R & ~31) + perm32(R & 31)) : R;
        voffA[i] = (unsigned)(R * K + C) * 2u; voffB[i] = (unsigned)(Rb * K + C) * 2u; }
    const size_t kstep = (size_t)(BK * 2);
    const size_t hstep = (size_t)HALF * K * 2;
    const size_t tstep = 2 * hstep;
    const unsigned ldsw = (unsigned)wid * 1024u;
    const int aoff = lds_byte(wr * 64 + fr, fq * 8), boff = lds_byte(wc * 32 + fr, fq * 8);
#define PG8_SA(b, h) (((b) * 2 + (h)) * HTB)
#define PG8_SB(b, h) ((4 + (b) * 2 + (h)) * HTB)
#define PG8_STAGE(bufoff, gbase, voff) do { _Pragma("unroll") for (int _i = 0; _i < 2; ++_i) \
        __builtin_amdgcn_global_load_lds((const unsigned*)((const char*)(gbase) + (voff)[_i]), (PG8_LAS unsigned*)(lds + (bufoff) + ldsw + _i * 8192), 16, 0, 0); } while (0)
#define PG8_LDA(dst, b, h) do { _Pragma("unroll") for (int m = 0; m < 4; ++m) _Pragma("unroll") for (int k = 0; k < 2; ++k) dst[m][k] = *(const PG8_LAS bf16x8*)(lds + PG8_SA(b, h) + aoff + m * 2048 + k * 1024); } while (0)
#define PG8_LDB(dst, b, h) do { _Pragma("unroll") for (int n = 0; n < 2; ++n) _Pragma("unroll") for (int k = 0; k < 2; ++k) dst[n][k] = *(const PG8_LAS bf16x8*)(lds + PG8_SB(b, h) + boff + n * 2048 + k * 1024); } while (0)
#define PG8_MMA(ai, bj, At, Bt) do { __builtin_amdgcn_s_setprio(1); _Pragma("unroll") for (int m = 0; m < 4; ++m) _Pragma("unroll") for (int n = 0; n < 2; ++n) _Pragma("unroll") for (int k = 0; k < 2; ++k) \
        acc[ai][bj][m][n] = __builtin_amdgcn_mfma_f32_16x16x32_bf16(Bt[n][k], At[m][k], acc[ai][bj][m][n], 0, 0, 0); __builtin_amdgcn_s_setprio(0); } while (0)
#define PG8_WAIT_V(n) asm volatile("s_waitcnt vmcnt(" #n ")" ::: "memory")
#define PG8_WAIT_L(n) asm volatile("s_waitcnt lgkmcnt(" #n ")" ::: "memory")
#define PG8_BAR __builtin_amdgcn_s_barrier()
#define PG8_SCHED __builtin_amdgcn_sched_barrier(0)
    Unit cur, nxt; int ui = 0;
    if (!S.next(0, cur)) return;
    f32x4 acc[2][2][4][2];
#pragma unroll
    for (int a = 0; a < 2; ++a)
#pragma unroll
        for (int b = 0; b < 2; ++b)
#pragma unroll
            for (int m = 0; m < 4; ++m)
#pragma unroll
                for (int n = 0; n < 2; ++n) acc[a][b][m][n] = (f32x4){0.f, 0.f, 0.f, 0.f};
    bf16x8 At[4][2], B0[2][2], B1[2][2];
    const char* cA = (const char*)g.A + (size_t)cur.pm * tstep + (size_t)cur.ks * kcb; const char* cB = (const char*)g.Bt + (size_t)cur.pn * tstep + (size_t)cur.ks * kcb;
    S.a_ready(cur);
    if constexpr (SP2) {
        PG8_STAGE(PG8_SB(0, 0), cB, voffB); PG8_STAGE(PG8_SB(0, 1), cB + hstep, voffB); PG8_STAGE(PG8_SA(0, 0), cA, voffA); PG8_STAGE(PG8_SA(0, 1), cA + hstep, voffA);
        if (wr == 1) PG8_BAR;
        PG8_WAIT_V(2); PG8_BAR;
        PG8_STAGE(PG8_SB(1, 0), cB + kstep, voffB); PG8_STAGE(PG8_SA(1, 0), cA + kstep, voffA); PG8_STAGE(PG8_SB(1, 1), cB + hstep + kstep, voffB);
        PG8_WAIT_V(6); PG8_BAR;
    } else {
        PG8_STAGE(PG8_SB(0, 0), cB, voffB); PG8_STAGE(PG8_SA(0, 0), cA, voffA); PG8_STAGE(PG8_SB(0, 1), cB + hstep, voffB); PG8_STAGE(PG8_SA(0, 1), cA + hstep, voffA);
        if (wr == 1) PG8_BAR;
        PG8_WAIT_V(4); PG8_BAR;
        PG8_STAGE(PG8_SB(1, 0), cB + kstep, voffB); PG8_STAGE(PG8_SA(1, 0), cA + kstep, voffA); PG8_STAGE(PG8_SB(1, 1), cB + hstep + kstep, voffB);
        PG8_WAIT_V(6); PG8_BAR;
    }
    for (;;) {
        const bool has_next = S.next(ui + 1, nxt);
        const char* nA = has_next ? (const char*)g.A + (size_t)nxt.pm * tstep + (size_t)nxt.ks * kcb : cA; const char* nB = has_next ? (const char*)g.Bt + (size_t)nxt.pn * tstep + (size_t)nxt.ks * kcb : cB;
        for (int t = 0; t < nt; t += 2) {
            const bool last = (t == nt - 2);
            const char* a1 = cA + (size_t)(t + 1) * kstep;
            const char* a2 = last ? nA : cA + (size_t)(t + 2) * kstep; const char* b2 = last ? nB : cB + (size_t)(t + 2) * kstep;
            const char* a3 = a2 + kstep; const char* b3 = b2 + kstep;
            if (last && has_next) S.a_ready(nxt);
            if constexpr (SP2) {
            PG8_LDB(B0, 0, 0); PG8_LDB(B1, 0, 1); PG8_SCHED; PG8_LDA(At, 0, 0); PG8_STAGE(PG8_SA(1, 1), a1 + hstep, voffA);
            PG8_WAIT_V(8); PG8_WAIT_L(0); PG8_BAR; PG8_MMA(0, 0, At, B0); PG8_MMA(0, 1, At, B1); PG8_BAR; PG8_SCHED;
            PG8_LDA(At, 0, 1); PG8_STAGE(PG8_SB(0, 0), b2, voffB); PG8_STAGE(PG8_SB(0, 1), b2 + hstep, voffB); PG8_STAGE(PG8_SA(0, 0), a2, voffA);
            PG8_WAIT_V(8); PG8_WAIT_L(0); PG8_BAR; PG8_MMA(1, 0, At, B0); PG8_MMA(1, 1, At, B1); PG8_BAR; PG8_SCHED;
            PG8_LDB(B0, 1, 0); PG8_LDB(B1, 1, 1); PG8_SCHED; PG8_LDA(At, 1, 0); PG8_STAGE(PG8_SA(0, 1), a2 + hstep, voffA);
            PG8_WAIT_V(8); PG8_WAIT_L(0); PG8_BAR; PG8_MMA(0, 0, At, B0); PG8_MMA(0, 1, At, B1); PG8_BAR; PG8_SCHED;
            PG8_LDA(At, 1, 1); PG8_STAGE(PG8_SB(1, 0), b3, voffB); PG8_STAGE(PG8_SB(1, 1), b3 + hstep, voffB); PG8_STAGE(PG8_SA(1, 0), a3, voffA);
            PG8_WAIT_V(8); PG8_WAIT_L(0); PG8_BAR; PG8_MMA(1, 0, At, B0); PG8_MMA(1, 1, At, B1); PG8_BAR; PG8_SCHED;
            } else {
            PG8_LDB(B0, 0, 0); PG8_SCHED; PG8_LDA(At, 0, 0); PG8_STAGE(PG8_SA(1, 1), a1 + hstep, voffA);
            PG8_WAIT_L(8); PG8_BAR; PG8_WAIT_L(0); PG8_MMA(0, 0, At, B0); PG8_BAR; PG8_SCHED;
            PG8_LDB(B1, 0, 1); PG8_STAGE(PG8_SB(0, 0), b2, voffB);
            PG8_BAR; PG8_WAIT_L(0); PG8_MMA(0, 1, At, B1); PG8_BAR;
            PG8_LDA(At, 0, 1); PG8_STAGE(PG8_SA(0, 0), a2, voffA);
            PG8_BAR; PG8_WAIT_L(0); PG8_MMA(1, 0, At, B0); PG8_BAR; PG8_SCHED;
            PG8_STAGE(PG8_SB(0, 1), b2 + hstep, voffB);
            PG8_WAIT_V(6); PG8_BAR; PG8_MMA(1, 1, At, B1); PG8_BAR;
            PG8_LDB(B0, 1, 0); PG8_SCHED; PG8_LDA(At, 1, 0); PG8_STAGE(PG8_SA(0, 1), a2 + hstep, voffA);
            PG8_WAIT_L(8); PG8_BAR; PG8_WAIT_L(0); PG8_MMA(0, 0, At, B0); PG8_BAR; PG8_SCHED;
            PG8_LDB(B1, 1, 1); PG8_STAGE(PG8_SB(1, 0), b3, voffB);
            PG8_BAR; PG8_WAIT_L(0); PG8_MMA(0, 1, At, B1); PG8_BAR;
            PG8_LDA(At, 1, 1); PG8_STAGE(PG8_SA(1, 0), a3, voffA);
            PG8_BAR; PG8_WAIT_L(0); PG8_MMA(1, 0, At, B0); PG8_BAR; PG8_SCHED;
            PG8_STAGE(PG8_SB(1, 1), b3 + hstep, voffB);
            PG8_WAIT_V(6); PG8_BAR; PG8_MMA(1, 1, At, B1); PG8_BAR;
            }
        }
        if constexpr (ALIGN_EPI) { if (wr == 0) PG8_BAR; }
        if constexpr (!Epi::AFTER_DRAIN) { E(acc, cur, wr, wc, fr, fq); S.done(cur); }
        if (!has_next) break;
#pragma unroll
        for (int a = 0; a < 2; ++a)
#pragma unroll
            for (int b = 0; b < 2; ++b)
#pragma unroll
                for (int m = 0; m < 4; ++m)
#pragma unroll
                    for (int n = 0; n < 2; ++n) acc[a][b][m][n] = (f32x4){0.f, 0.f, 0.f, 0.f};
        cur = nxt; cA = nA; cB = nB; ++ui;
        if constexpr (ALIGN_EPI) { if (wr == 1) PG8_BAR; }
    }
    PG8_WAIT_V(0);
    if constexpr (!ALIGN_EPI) { if (wr == 0) PG8_BAR; }
    PG8_BAR;
    if constexpr (Epi::AFTER_DRAIN) { E.fused(acc, cur, wr, wc, fr, fq, lds, wid, lane); S.done(cur); }
#undef PG8_SA
#undef PG8_SB
#undef PG8_STAGE
#undef PG8_LDA
#undef PG8_LDB
#undef PG8_MMA
#undef PG8_WAIT_V
#undef PG8_WAIT_L
#undef PG8_BAR
#undef PG8_SCHED
}
}
__device__ __forceinline__ int tidx() { int t = threadIdx.x; asm volatile("" : "+v"(t)); return t; }
namespace att {
constexpr int NW=8,QBLK=32,KVBLK=64;
using bf16=__hip_bfloat16;
using bf16x8=__attribute__((ext_vector_type(8)))short;
using s16x4=__attribute__((ext_vector_type(4)))short;
using f32x16=__attribute__((ext_vector_type(16)))float;
using u32x4=__attribute__((ext_vector_type(4)))unsigned;
__device__ __forceinline__ int crow(int r,int hi){return (r&3)+8*(r>>2)+4*hi;}
#define SBAR() __builtin_amdgcn_sched_barrier(0)
__device__ __forceinline__ float max3f(float a,float b,float c){float r;asm("v_max3_f32 %0, %1, %2, %3":"=v"(r):"v"(a),"v"(b),"v"(c));return r;}
__device__ __forceinline__ float max2f(float a,float b){float r;asm("v_max_f32_e32 %0, %1, %2":"=v"(r):"v"(a),"v"(b));return r;}
__device__ __forceinline__ float fadd_s(float a,float b){float r;asm("v_add_f32_e32 %0, %1, %2":"=v"(r):"v"(a),"v"(b));return r;}
__device__ __forceinline__ float fsub_s(float a,float b){float r;asm("v_sub_f32_e32 %0, %1, %2":"=v"(r):"v"(a),"v"(b));return r;}
typedef float f32x2_t __attribute__((ext_vector_type(2))); typedef __bf16 bf16x2_t __attribute__((ext_vector_type(2)));
__device__ __forceinline__ unsigned cvtpk_s(float lo,float hi){f32x2_t v={lo,hi};bf16x2_t b=__builtin_convertvector(v,bf16x2_t);return __builtin_bit_cast(unsigned,b);}
__device__ __forceinline__ void qkt(f32x16&p0,f32x16&p1,const char*Kslot,const bf16x8*qr,const f32x16&negm,int r32,int hi){
  const char*kb=Kslot+hi*1024+r32*16;
  #pragma unroll
  for(int d0=0;d0<4;++d0){
    const bf16x8 b0=*reinterpret_cast<const bf16x8*>(kb+d0*2048);
    const bf16x8 b1=*reinterpret_cast<const bf16x8*>(kb+d0*2048+512);
    if(d0==0){p0=__builtin_amdgcn_mfma_f32_32x32x16_bf16(b0,qr[0],negm,0,0,0);p1=__builtin_amdgcn_mfma_f32_32x32x16_bf16(b1,qr[0],negm,0,0,0);}
    else{p0=__builtin_amdgcn_mfma_f32_32x32x16_bf16(b0,qr[d0],p0,0,0,0);p1=__builtin_amdgcn_mfma_f32_32x32x16_bf16(b1,qr[d0],p1,0,0,0);}}
}
__device__ __forceinline__ float rowmax(const f32x16&p0,const f32x16&p1){
  float a=max3f(p0[0],p0[1],p1[0]),b=max3f(p0[2],p0[3],p1[1]);a=max3f(a,p1[2],p1[3]);
  #pragma unroll
  for(int r=4;r<16;r+=4){a=max3f(a,p0[r],p0[r+1]);b=max3f(b,p0[r+2],p0[r+3]);a=max3f(a,p1[r],p1[r+1]);b=max3f(b,p1[r+2],p1[r+3]);}
  const float m=max2f(a,b);
  auto rr=__builtin_amdgcn_permlane32_swap(__float_as_uint(m),__float_as_uint(m),false,false);
  return max2f(__uint_as_float(rr[0]),__uint_as_float(rr[1]));
}
__device__ __forceinline__ void pv(f32x16*o,int vb,bf16x8 pa0,bf16x8 pa1,bf16x8 pa2,bf16x8 pa3){
  #pragma unroll
  for(int d0=0;d0<2;++d0){s16x4 lo[4],hi[4];
    #pragma unroll
    for(int ks=0;ks<4;++ks){
      asm volatile("ds_read_b64_tr_b16 %0,%1 offset:%c2":"=&v"(lo[ks]):"v"(vb),"i"(d0*4096+ks*1024):"memory");
      asm volatile("ds_read_b64_tr_b16 %0,%1 offset:%c2":"=&v"(hi[ks]):"v"(vb),"i"(d0*4096+ks*1024+512):"memory");}
    asm volatile("s_waitcnt lgkmcnt(0)":::"memory");SBAR();
    #define PK(k) (bf16x8){lo[k][0],lo[k][1],lo[k][2],lo[k][3],hi[k][0],hi[k][1],hi[k][2],hi[k][3]}
    o[d0]=__builtin_amdgcn_mfma_f32_32x32x16_bf16(pa0,PK(0),o[d0],0,0,0);
    o[d0]=__builtin_amdgcn_mfma_f32_32x32x16_bf16(pa1,PK(1),o[d0],0,0,0);
    o[d0]=__builtin_amdgcn_mfma_f32_32x32x16_bf16(pa2,PK(2),o[d0],0,0,0);
    o[d0]=__builtin_amdgcn_mfma_f32_32x32x16_bf16(pa3,PK(3),o[d0],0,0,0);
    #undef PK
  }
}
constexpr int NSLOT=3, SLOTB=8192;
constexpr int LDS_K=0, LDS_V=NSLOT*SLOTB, LDS_WS=2*NSLOT*SLOTB, LDS_OST=LDS_WS+NW*64*4, LDS_BYTES=LDS_OST+NW*4096;
constexpr float C2=0.125f*1.4426950408889634f;
__device__ __forceinline__ void glds16(const void*gsrc,unsigned lds_dst){unsigned keep;
  asm volatile("s_mov_b32 %0, m0\n\ts_mov_b32 m0, %2\n\ts_nop 0\n\tglobal_load_lds_dwordx4 %1, off\n\ts_mov_b32 m0, %0":"=&s"(keep):"v"(gsrc),"s"(lds_dst):"memory");}
#define WAIT_BAR(N) asm volatile("s_waitcnt vmcnt(" #N ") lgkmcnt(0)\n\ts_barrier":::"memory")
typedef __attribute__((address_space(3))) const char* lds_cptr;
typedef short v4i16_t __attribute__((ext_vector_type(4)));
__device__ __forceinline__ void kload8(bf16x8*kf,lds_cptr kp){
  kf[0]=*(const __attribute__((address_space(3))) bf16x8*)(kp);      kf[1]=*(const __attribute__((address_space(3))) bf16x8*)(kp+512);
  kf[2]=*(const __attribute__((address_space(3))) bf16x8*)(kp+2048); kf[3]=*(const __attribute__((address_space(3))) bf16x8*)(kp+2560);
  kf[4]=*(const __attribute__((address_space(3))) bf16x8*)(kp+4096); kf[5]=*(const __attribute__((address_space(3))) bf16x8*)(kp+4608);
  kf[6]=*(const __attribute__((address_space(3))) bf16x8*)(kp+6144); kf[7]=*(const __attribute__((address_space(3))) bf16x8*)(kp+6656);
}
__device__ __forceinline__ void kload2(bf16x8*kf,lds_cptr kp,int j){ kf[2*j]=*(const __attribute__((address_space(3))) bf16x8*)(kp+j*2048); kf[2*j+1]=*(const __attribute__((address_space(3))) bf16x8*)(kp+j*2048+512); }
__device__ __forceinline__ s16x4 vtr(lds_cptr p){ return __builtin_bit_cast(s16x4,__builtin_amdgcn_ds_read_tr16_b64_v4i16((__attribute__((address_space(3))) v4i16_t*)p)); }
#ifndef ATTN_STORE16
#define ATTN_STORE16(p,v) (*(u32x4*)(p)=(v))
#endif
template<int THRL> __device__ __forceinline__ void attn_unit_p(const bf16*Qu,int QP,const bf16*__restrict__ Kh,const bf16*__restrict__ Vh,int KP,int NT,bf16*Ou,int OP,char*shm){
  const int tid=tidx(),lane=tid&63,r32=lane&31,hi=lane>>5; const int wid=__builtin_amdgcn_readfirstlane(tid>>6);
  const bf16*Qw=Qu+(long)(wid*QBLK)*QP;
  const unsigned lds0=(unsigned)(uintptr_t)shm;
  float*wsf=(float*)(shm+LDS_WS)+wid*64;
  const bf16*ksrc=Kh+(long)lane*KP+wid*8;
  const bf16*vsrc=Vh+(long)(16*(wid&3)+(lane>>2))*KP+(wid>>2)*32+(lane&3)*8;
  const unsigned kdst=lds0+LDS_K+wid*1024, vdst=lds0+LDS_V+wid*1024;
  #define DMA_K(t,slot) glds16(ksrc+(long)(t)*KVBLK*KP,(unsigned)__builtin_amdgcn_readfirstlane(kdst+(slot)))
  #define DMA_V(t,slot) glds16(vsrc+(long)(t)*KVBLK*KP,(unsigned)__builtin_amdgcn_readfirstlane(vdst+(slot)))
  const int vb0=(int)(lds0+LDS_V)+((lane>>4)&1)*32+(lane&3)*8+(4*hi+((lane&15)>>2))*64;
  const char*Kbase=shm+LDS_K; bf16x8 kf[8];
  const lds_cptr shm3=(lds_cptr)shm; const lds_cptr kp0=shm3+LDS_K+hi*1024+r32*16; const lds_cptr vp0=shm3+LDS_V+((lane>>4)&1)*32+(lane&3)*8+(4*hi+((lane&15)>>2))*64;
  DMA_K(0,0);DMA_V(0,0);DMA_K(1,SLOTB);
  bf16x8 qr[4];
  #pragma unroll
  for(int d0=0;d0<4;++d0)qr[d0]=*reinterpret_cast<const bf16x8*>(&Qw[(long)r32*QP+d0*16+hi*8]);
  float mhat=0.f,l_reg=0.f;f32x16 o[2];o[0]=f32x16{};o[1]=f32x16{};f32x16 negm=f32x16{};asm volatile("":"+v"(negm));
  const int qrel=wid*QBLK+r32;
  #define CMASK(P0,P1,t) do{}while(0)
  bool resc=false;
  #define START(P0,P1) do{ const float rm=rowmax(P0,P1); resc=false; \
    { const float dl=rm; mhat=fadd_s(mhat,dl); \
      _Pragma("unroll") for(int r=0;r<16;++r){P0[r]=fsub_s(P0[r],dl);P1[r]=fsub_s(P1[r],dl);} \
      _Pragma("unroll") for(int r=0;r<16;++r)negm[r]=-mhat; asm volatile("":"+v"(negm)); } \
    _Pragma("unroll") for(int r=0;r<16;++r)P0[r]=__builtin_amdgcn_exp2f(P0[r]); }while(0)
  #define RESC() do{ if(resc){ asm volatile("s_waitcnt lgkmcnt(0)":::"memory"); \
      _Pragma("unroll") for(int d_=0;d_<2;++d_) _Pragma("unroll") for(int r=0;r<16;++r)o[d_][r]*=wsf[crow(r,hi)]; } }while(0)
  f32x16 pA0,pA1,pB0,pB1;
  int sl_prev=0,sl_cur=0,sl_next=SLOTB;
  #define ROT() do{sl_prev=sl_cur;sl_cur=sl_next;sl_next=(sl_next==(NSLOT-1)*SLOTB)?0:sl_next+SLOTB;}while(0)
  DMA_K(2,2*SLOTB);
  WAIT_BAR(3);
  qkt(pA0,pA1,Kbase,qr,negm,r32,hi);asm volatile("s_nop 15\n\ts_nop 7":"+v"(pA0),"+v"(pA1));CMASK(pA0,pA1,0);
  START(pA0,pA1);
  _Pragma("unroll") for(int r=0;r<16;++r)pA1[r]=__builtin_amdgcn_exp2f(pA1[r]);
  WAIT_BAR(0);
  DMA_K(3,0);DMA_V(1,SLOTB);
  ROT();
  kload8(kf,kp0+sl_cur);
  WAIT_BAR(2);
  s16x4 vlo[8],vhi[8]; u32x4 pw0,pw1,pw2,pw3;
  #define PKW(P,B) cvtpk_s(P[B],P[B+1])
  #define PAF(k) __builtin_bit_cast(bf16x8,pw##k)
  #define VFR(i) (bf16x8){vlo[i][0],vlo[i][1],vlo[i][2],vlo[i][3],vhi[i][0],vhi[i][1],vhi[i][2],vhi[i][3]}
  #define PIN(x) asm volatile("":"+v"(x))
  #define MX3(a,b,c) __builtin_fmaxf(__builtin_fmaxf((a),(b)),(c))
  #define GAPA(MF,A0,A1,A2,A3,W0,W1,PW) do{ MF; sacc+=A0; sacc+=A1; sacc+=A2; sacc+=A3; PIN(sacc); W0; W1; PIN(PW); SBAR(); }while(0)
  #define EX(v) __builtin_amdgcn_exp2f(v)
  #define GAPB(MF,X,B) do{ MF; X[B]=EX(X[B]); X[B+1]=EX(X[B+1]); X[B+2]=EX(X[B+2]); X[B+3]=EX(X[B+3]); PIN(X); SBAR(); }while(0)
  #define VRD(i) do{ vlo[i]=vtr(vp_+(((i)>>2)*4096+((i)&3)*1024)); vhi[i]=vtr(vp_+(((i)>>2)*4096+((i)&3)*1024+512)); }while(0)
  #define KRD(G,j) do{ if(G){ kload2(kf,kp0+sl_next,j); SBAR(); } }while(0)
  #define STEP(C0,C1,P0,P1,t,GK,GV,GL) do{ SBAR(); \
    const lds_cptr vp_=vp0+sl_prev; \
    VRD(0); SBAR(); float sacc=(P0[0]+P0[1]); \
    GAPA(C0=__builtin_amdgcn_mfma_f32_32x32x16_bf16(kf[0],qr[0],negm,0,0,0), P0[2],P0[3],P0[4],P0[5],     pw0[0]=PKW(P0,0), pw0[1]=PKW(P0,2), pw0); \
    VRD(4); SBAR(); GAPA(C1=__builtin_amdgcn_mfma_f32_32x32x16_bf16(kf[1],qr[0],negm,0,0,0), P0[6],P0[7],P0[8],P0[9],     pw0[2]=PKW(P0,4), pw0[3]=PKW(P0,6), pw0); \
    VRD(1); SBAR(); GAPA(C0=__builtin_amdgcn_mfma_f32_32x32x16_bf16(kf[2],qr[1],C0,0,0,0),   P0[10],P0[11],P0[12],P0[13], pw1[0]=PKW(P0,8), pw1[1]=PKW(P0,10), pw1); \
    VRD(5); SBAR(); GAPA(C1=__builtin_amdgcn_mfma_f32_32x32x16_bf16(kf[3],qr[1],C1,0,0,0),   P0[14],P0[15],P1[0],P1[1],   pw1[2]=PKW(P0,12),pw1[3]=PKW(P0,14), pw1); \
    VRD(2); SBAR(); GAPA(C0=__builtin_amdgcn_mfma_f32_32x32x16_bf16(kf[4],qr[2],C0,0,0,0),   P1[2],P1[3],P1[4],P1[5],     pw2[0]=PKW(P1,0), pw2[1]=PKW(P1,2), pw2); \
    VRD(6); SBAR(); GAPA(C1=__builtin_amdgcn_mfma_f32_32x32x16_bf16(kf[5],qr[2],C1,0,0,0),   P1[6],P1[7],P1[8],P1[9],     pw2[2]=PKW(P1,4), pw2[3]=PKW(P1,6), pw2); \
    VRD(3); SBAR(); GAPA(C0=__builtin_amdgcn_mfma_f32_32x32x16_bf16(kf[6],qr[3],C0,0,0,0),   P1[10],P1[11],P1[12],P1[13], pw3[0]=PKW(P1,8), pw3[1]=PKW(P1,10), pw3); \
    VRD(7); SBAR(); GAPA(C1=__builtin_amdgcn_mfma_f32_32x32x16_bf16(kf[7],qr[3],C1,0,0,0),   P1[14],P1[15],0.f,0.f,       pw3[2]=PKW(P1,12),pw3[3]=PKW(P1,14), pw3); \
    l_reg+=sacc; \
    if(GK){DMA_K((t)+3,sl_cur);} if(GV){DMA_V((t)+1,sl_next);} \
    CMASK(C0,C1,t); \
    { float a=MX3(C0[0],C0[1],C1[0]),b=MX3(C0[2],C0[3],C1[1]); a=MX3(a,C1[2],C1[3]); \
      _Pragma("unroll") for(int r=4;r<16;r+=4){a=MX3(a,C0[r],C0[r+1]);b=MX3(b,C0[r+2],C0[r+3]);a=MX3(a,C1[r],C1[r+1]);b=MX3(b,C1[r+2],C1[r+3]);} \
      float rm=__builtin_fmaxf(a,b); { auto rr=__builtin_amdgcn_permlane32_swap(__float_as_uint(rm),__float_as_uint(rm),false,false); rm=__builtin_fmaxf(__uint_as_float(rr[0]),__uint_as_float(rr[1])); } \
      resc=false; \
      if(__builtin_expect(__any(rm>(float)THRL),0)){ const float dl=__builtin_fmaxf(rm,0.f); mhat+=dl; \
        _Pragma("unroll") for(int r=0;r<16;++r){C0[r]-=dl;C1[r]-=dl;} \
        _Pragma("unroll") for(int r=0;r<16;++r)negm[r]=-mhat; asm volatile("":"+v"(negm)); \
        const float f=__builtin_amdgcn_exp2f(-dl); l_reg*=f; if(hi==0)wsf[r32]=f; resc=true; } } \
    SBAR(); \
    GAPB(o[0]=__builtin_amdgcn_mfma_f32_32x32x16_bf16(PAF(0),VFR(0),o[0],0,0,0), C0,0); \
    GAPB(o[1]=__builtin_amdgcn_mfma_f32_32x32x16_bf16(PAF(0),VFR(4),o[1],0,0,0), C0,4); \
    KRD(GL,0); GAPB(o[0]=__builtin_amdgcn_mfma_f32_32x32x16_bf16(PAF(1),VFR(1),o[0],0,0,0), C0,8); \
    KRD(GL,1); GAPB(o[1]=__builtin_amdgcn_mfma_f32_32x32x16_bf16(PAF(1),VFR(5),o[1],0,0,0), C0,12); \
    KRD(GL,2); GAPB(o[0]=__builtin_amdgcn_mfma_f32_32x32x16_bf16(PAF(2),VFR(2),o[0],0,0,0), C1,0); \
    KRD(GL,3); GAPB(o[1]=__builtin_amdgcn_mfma_f32_32x32x16_bf16(PAF(2),VFR(6),o[1],0,0,0), C1,4); \
    GAPB(o[0]=__builtin_amdgcn_mfma_f32_32x32x16_bf16(PAF(3),VFR(3),o[0],0,0,0), C1,8); \
    GAPB(o[1]=__builtin_amdgcn_mfma_f32_32x32x16_bf16(PAF(3),VFR(7),o[1],0,0,0), C1,12); \
    }while(0)
  int t=1;
  #undef CMASK
  #define CMASK(P0,P1,t) do{}while(0)
  for(;t+5<NT;t+=2){
    STEP(pB0,pB1,pA0,pA1,t,true,true,true);     WAIT_BAR(2); RESC(); ROT();
    STEP(pA0,pA1,pB0,pB1,t+1,true,true,true);   WAIT_BAR(2); RESC(); ROT();
  }
  #undef CMASK
  #define CMASK(P0,P1,t) do{}while(0)
  #define ENDW(tt) do{ if((tt)+3<NT){WAIT_BAR(2);} else if((tt)+2<NT){WAIT_BAR(1);} else {WAIT_BAR(0);} }while(0)
  for(;t+1<NT;t+=2){
    STEP(pB0,pB1,pA0,pA1,t,(t+3<NT),(t+1<NT),(t+1<NT));       ENDW(t);   RESC(); ROT();
    STEP(pA0,pA1,pB0,pB1,t+1,(t+4<NT),(t+2<NT),(t+2<NT));     ENDW(t+1); RESC(); ROT();
  }
  STEP(pB0,pB1,pA0,pA1,NT-1,false,false,false); RESC();
  { float sacc=pB0[0]+pB0[1]; _Pragma("unroll") for(int r=2;r<16;++r)sacc+=pB0[r]; _Pragma("unroll") for(int r=0;r<16;++r)sacc+=pB1[r]; l_reg+=sacc;
    pw0=(u32x4){PKW(pB0,0),PKW(pB0,2),PKW(pB0,4),PKW(pB0,6)};pw1=(u32x4){PKW(pB0,8),PKW(pB0,10),PKW(pB0,12),PKW(pB0,14)};pw2=(u32x4){PKW(pB1,0),PKW(pB1,2),PKW(pB1,4),PKW(pB1,6)};pw3=(u32x4){PKW(pB1,8),PKW(pB1,10),PKW(pB1,12),PKW(pB1,14)};
    SBAR(); pv(o,vb0+sl_cur,PAF(0),PAF(1),PAF(2),PAF(3)); }
  #undef PKW
  #undef PAF
  #undef VFR
  #undef PIN
  #undef MX3
  #undef GAPA
  #undef GAPB
  #undef EX
  #undef VRD
  #undef KRD
  #undef STEP
  #undef ENDW
  {auto rr=__builtin_amdgcn_permlane32_swap(__float_as_uint(l_reg),__float_as_uint(l_reg),false,false);l_reg=__uint_as_float(rr[0])+__uint_as_float(rr[1]);}
  if(hi==0)wsf[32+r32]=l_reg;asm volatile("s_waitcnt lgkmcnt(0)":::"memory");
  float rli[16];
  #pragma unroll
  for(int r=0;r<16;++r)rli[r]=__builtin_amdgcn_rcpf(wsf[32+crow(r,hi)]);
  bf16*Ow=Ou+(long)(wid*QBLK)*OP;
  { bf16*stg=(bf16*)(shm+LDS_OST)+wid*2048;
    #pragma unroll
    for(int r=0;r<16;++r){const int orow=crow(r,hi);
      #pragma unroll
      for(int d0=0;d0<2;++d0)stg[orow*64+d0*32+r32]=__float2bfloat16(o[d0][r]*rli[r]);}
    asm volatile("s_waitcnt lgkmcnt(0)":::"memory");
    #pragma unroll
    for(int i=0;i<4;++i){const int row=i*8+(lane>>3),ch=lane&7; const u32x4 v=*(const u32x4*)(stg+row*64+ch*8); ATTN_STORE16(Ow+(long)row*OP+ch*8,v);} }
  asm volatile("s_waitcnt lgkmcnt(0)\n\ts_barrier":::"memory");
  #undef DMA_K
  #undef DMA_V
  #undef CMASK
  #undef START
  #undef RESC
  #undef ROT
}
#ifndef ATTN_STORE16
#define ATTN_STORE16(p,v) (*(u32x4*)(p)=(v))
#endif
struct NaP { int nW, R0, i0; long jump; const float* rpbs; };
template<int THRL> __device__ __forceinline__ void attn_unit_na(const bf16*Qu,int QP,const bf16*__restrict__ Kh,const bf16*__restrict__ Vh,int KP,int NT,bf16*Ou,int OP,char*shm,const NaP na){
  const int tid=tidx(),lane=tid&63,r32=lane&31,hi=lane>>5; const int wid=__builtin_amdgcn_readfirstlane(tid>>6);
  const bf16*Qw=Qu+(long)(wid*QBLK)*QP;
  const unsigned lds0=(unsigned)(uintptr_t)shm;
  float*wsf=(float*)(shm+LDS_WS)+wid*64;
  const bf16*ksrc=Kh+(long)lane*KP+wid*8;
  const bf16*vsrc=Vh+(long)(16*(wid&3)+(lane>>2))*KP+(wid>>2)*32+(lane&3)*8;
  const unsigned kdst=lds0+LDS_K+wid*1024, vdst=lds0+LDS_V+wid*1024;
  #define NA_TOFF(t) ((long)((t)<na.nW+4?(t):na.nW+3)*KVBLK+((t)>=na.nW?na.jump:0L))
  const int na_qi=na.i0+(wid>>1), na_qc=32*(wid&1)+r32, na_rs=min(max(na_qi-4,0),56), na_cs=min(max(na_qc-8,0),48);
  #define NA_MASK(P0,P1,t) do{ const int t_=(t); if(t_<na.nW){ const int krow_=na.R0+t_; if(krow_<na_rs||krow_>na_rs+7){ _Pragma("unroll") for(int r=0;r<16;++r){P0[r]=-30000.f;P1[r]=-30000.f;} } \
      else { const int dr_=(krow_-na_qi+7)*31+15-na_qc; _Pragma("unroll") for(int r=0;r<16;++r){ const int k0_=crow(r,hi),k1_=k0_+32; const bool v0_=(k0_>=na_cs)&&(k0_<na_cs+16),v1_=(k1_>=na_cs)&&(k1_<na_cs+16); \
          const float b0_=na.rpbs[v0_?dr_+k0_:0],b1_=na.rpbs[v1_?dr_+k1_:0]; P0[r]=v0_?P0[r]+b0_:-30000.f; P1[r]=v1_?P1[r]+b1_:-30000.f; } } } \
    else if(t_>=na.nW+4){ _Pragma("unroll") for(int r=0;r<16;++r){P0[r]=-30000.f;P1[r]=-30000.f;} } }while(0)
  #define DMA_K(t,slot) glds16(ksrc+NA_TOFF(t)*KP,(unsigned)__builtin_amdgcn_readfirstlane(kdst+(slot)))
  #define DMA_V(t,slot) glds16(vsrc+NA_TOFF(t)*KP,(unsigned)__builtin_amdgcn_readfirstlane(vdst+(slot)))
  const int vb0=(int)(lds0+LDS_V)+((lane>>4)&1)*32+(lane&3)*8+(4*hi+((lane&15)>>2))*64;
  const char*Kbase=shm+LDS_K; bf16x8 kf[8];
  const lds_cptr shm3=(lds_cptr)shm; const lds_cptr kp0=shm3+LDS_K+hi*1024+r32*16; const lds_cptr vp0=shm3+LDS_V+((lane>>4)&1)*32+(lane&3)*8+(4*hi+((lane&15)>>2))*64;
  DMA_K(0,0);DMA_V(0,0);DMA_K(1,SLOTB);
  bf16x8 qr[4];
  #pragma unroll
  for(int d0=0;d0<4;++d0)qr[d0]=*reinterpret_cast<const bf16x8*>(&Qw[(long)r32*QP+d0*16+hi*8]);
  float mhat=0.f,l_reg=0.f;f32x16 o[2];o[0]=f32x16{};o[1]=f32x16{};
  const int qrel=wid*QBLK+r32;
  #define CMASK(P0,P1,t) NA_MASK(P0,P1,t)
  bool resc=false;
  #define START(P0,P1) do{ const float rm=rowmax(P0,P1); resc=false; \
    { const float dl=rm; mhat=fadd_s(mhat,dl); \
      _Pragma("unroll") for(int r=0;r<16;++r){P0[r]=fsub_s(P0[r],dl);P1[r]=fsub_s(P1[r],dl);} \
      } \
    _Pragma("unroll") for(int r=0;r<16;++r)P0[r]=__builtin_amdgcn_exp2f(P0[r]); }while(0)
  #define RESC() do{ if(resc){ asm volatile("s_waitcnt lgkmcnt(0)":::"memory"); \
      _Pragma("unroll") for(int d_=0;d_<2;++d_) _Pragma("unroll") for(int r=0;r<16;++r)o[d_][r]*=wsf[crow(r,hi)]; } }while(0)
  f32x16 pA0,pA1,pB0,pB1;
  int sl_prev=0,sl_cur=0,sl_next=SLOTB;
  #define ROT() do{sl_prev=sl_cur;sl_cur=sl_next;sl_next=(sl_next==(NSLOT-1)*SLOTB)?0:sl_next+SLOTB;}while(0)
  DMA_K(2,2*SLOTB);
  WAIT_BAR(3);
  qkt(pA0,pA1,Kbase,qr,f32x16{},r32,hi);asm volatile("s_nop 15\n\ts_nop 7":"+v"(pA0),"+v"(pA1));CMASK(pA0,pA1,0);
  START(pA0,pA1);
  _Pragma("unroll") for(int r=0;r<16;++r)pA1[r]=__builtin_amdgcn_exp2f(pA1[r]);
  WAIT_BAR(0);
  DMA_K(3,0);DMA_V(1,SLOTB);
  ROT();
  kload8(kf,kp0+sl_cur);
  WAIT_BAR(2);
  s16x4 vlo[8],vhi[8]; u32x4 pw0,pw1,pw2,pw3;
  #define PKW(P,B) cvtpk_s(P[B],P[B+1])
  #define PAF(k) __builtin_bit_cast(bf16x8,pw##k)
  #define VFR(i) (bf16x8){vlo[i][0],vlo[i][1],vlo[i][2],vlo[i][3],vhi[i][0],vhi[i][1],vhi[i][2],vhi[i][3]}
  #define PIN(x) asm volatile("":"+v"(x))
  #define MX3(a,b,c) __builtin_fmaxf(__builtin_fmaxf((a),(b)),(c))
  #define GAPA(MF,A0,A1,A2,A3,W0,W1,PW) do{ MF; sacc+=A0; sacc+=A1; sacc+=A2; sacc+=A3; PIN(sacc); W0; W1; PIN(PW); SBAR(); }while(0)
  #define EX(v) __builtin_amdgcn_exp2f(v)
  #define GAPB(MF,X,B) do{ MF; X[B]=EX(X[B]); X[B+1]=EX(X[B+1]); X[B+2]=EX(X[B+2]); X[B+3]=EX(X[B+3]); PIN(X); SBAR(); }while(0)
  #define VRD(i) do{ vlo[i]=vtr(vp_+(((i)>>2)*4096+((i)&3)*1024)); vhi[i]=vtr(vp_+(((i)>>2)*4096+((i)&3)*1024+512)); }while(0)
  #define KRD(G,j) do{ if(G){ kload2(kf,kp0+sl_next,j); SBAR(); } }while(0)
  #define STEP(C0,C1,P0,P1,t,GK,GV,GL) do{ SBAR(); \
    const lds_cptr vp_=vp0+sl_prev; \
    VRD(0); SBAR(); float sacc=(P0[0]+P0[1]); \
    GAPA(C0=__builtin_amdgcn_mfma_f32_32x32x16_bf16(kf[0],qr[0],f32x16{},0,0,0), P0[2],P0[3],P0[4],P0[5],     pw0[0]=PKW(P0,0), pw0[1]=PKW(P0,2), pw0); \
    VRD(4); SBAR(); GAPA(C1=__builtin_amdgcn_mfma_f32_32x32x16_bf16(kf[1],qr[0],f32x16{},0,0,0), P0[6],P0[7],P0[8],P0[9],     pw0[2]=PKW(P0,4), pw0[3]=PKW(P0,6), pw0); \
    VRD(1); SBAR(); GAPA(C0=__builtin_amdgcn_mfma_f32_32x32x16_bf16(kf[2],qr[1],C0,0,0,0),   P0[10],P0[11],P0[12],P0[13], pw1[0]=PKW(P0,8), pw1[1]=PKW(P0,10), pw1); \
    VRD(5); SBAR(); GAPA(C1=__builtin_amdgcn_mfma_f32_32x32x16_bf16(kf[3],qr[1],C1,0,0,0),   P0[14],P0[15],P1[0],P1[1],   pw1[2]=PKW(P0,12),pw1[3]=PKW(P0,14), pw1); \
    VRD(2); SBAR(); GAPA(C0=__builtin_amdgcn_mfma_f32_32x32x16_bf16(kf[4],qr[2],C0,0,0,0),   P1[2],P1[3],P1[4],P1[5],     pw2[0]=PKW(P1,0), pw2[1]=PKW(P1,2), pw2); \
    VRD(6); SBAR(); GAPA(C1=__builtin_amdgcn_mfma_f32_32x32x16_bf16(kf[5],qr[2],C1,0,0,0),   P1[6],P1[7],P1[8],P1[9],     pw2[2]=PKW(P1,4), pw2[3]=PKW(P1,6), pw2); \
    VRD(3); SBAR(); GAPA(C0=__builtin_amdgcn_mfma_f32_32x32x16_bf16(kf[6],qr[3],C0,0,0,0),   P1[10],P1[11],P1[12],P1[13], pw3[0]=PKW(P1,8), pw3[1]=PKW(P1,10), pw3); \
    VRD(7); SBAR(); GAPA(C1=__builtin_amdgcn_mfma_f32_32x32x16_bf16(kf[7],qr[3],C1,0,0,0),   P1[14],P1[15],0.f,0.f,       pw3[2]=PKW(P1,12),pw3[3]=PKW(P1,14), pw3); \
    l_reg+=sacc; \
    if(GK){DMA_K((t)+3,sl_cur);} if(GV){DMA_V((t)+1,sl_next);} \
    { const float mh_=mhat; _Pragma("unroll") for(int r=0;r<16;++r){C0[r]-=mh_;C1[r]-=mh_;} } \
    CMASK(C0,C1,t); \
    { float a=MX3(C0[0],C0[1],C1[0]),b=MX3(C0[2],C0[3],C1[1]); a=MX3(a,C1[2],C1[3]); \
      _Pragma("unroll") for(int r=4;r<16;r+=4){a=MX3(a,C0[r],C0[r+1]);b=MX3(b,C0[r+2],C0[r+3]);a=MX3(a,C1[r],C1[r+1]);b=MX3(b,C1[r+2],C1[r+3]);} \
      float rm=__builtin_fmaxf(a,b); { auto rr=__builtin_amdgcn_permlane32_swap(__float_as_uint(rm),__float_as_uint(rm),false,false); rm=__builtin_fmaxf(__uint_as_float(rr[0]),__uint_as_float(rr[1])); } \
      resc=false; \
      if(__builtin_expect(__any(rm>(float)THRL),0)){ const float dl=__builtin_fmaxf(rm,0.f); mhat+=dl; \
        _Pragma("unroll") for(int r=0;r<16;++r){C0[r]-=dl;C1[r]-=dl;} \
        const float f=__builtin_amdgcn_exp2f(-dl); l_reg*=f; if(hi==0)wsf[r32]=f; resc=true; } } \
    SBAR(); \
    GAPB(o[0]=__builtin_amdgcn_mfma_f32_32x32x16_bf16(PAF(0),VFR(0),o[0],0,0,0), C0,0); \
    GAPB(o[1]=__builtin_amdgcn_mfma_f32_32x32x16_bf16(PAF(0),VFR(4),o[1],0,0,0), C0,4); \
    KRD(GL,0); GAPB(o[0]=__builtin_amdgcn_mfma_f32_32x32x16_bf16(PAF(1),VFR(1),o[0],0,0,0), C0,8); \
    KRD(GL,1); GAPB(o[1]=__builtin_amdgcn_mfma_f32_32x32x16_bf16(PAF(1),VFR(5),o[1],0,0,0), C0,12); \
    KRD(GL,2); GAPB(o[0]=__builtin_amdgcn_mfma_f32_32x32x16_bf16(PAF(2),VFR(2),o[0],0,0,0), C1,0); \
    KRD(GL,3); GAPB(o[1]=__builtin_amdgcn_mfma_f32_32x32x16_bf16(PAF(2),VFR(6),o[1],0,0,0), C1,4); \
    GAPB(o[0]=__builtin_amdgcn_mfma_f32_32x32x16_bf16(PAF(3),VFR(3),o[0],0,0,0), C1,8); \
    GAPB(o[1]=__builtin_amdgcn_mfma_f32_32x32x16_bf16(PAF(3),VFR(7),o[1],0,0,0), C1,12); \
    }while(0)
  int t=1;
  #undef CMASK
  #define CMASK(P0,P1,t) NA_MASK(P0,P1,t)
  for(;t+5<NT;t+=2){
    STEP(pB0,pB1,pA0,pA1,t,true,true,true);     WAIT_BAR(2); RESC(); ROT();
    STEP(pA0,pA1,pB0,pB1,t+1,true,true,true);   WAIT_BAR(2); RESC(); ROT();
  }
  #undef CMASK
  #define CMASK(P0,P1,t) NA_MASK(P0,P1,t)
  #define ENDW(tt) do{ if((tt)+3<NT){WAIT_BAR(2);} else if((tt)+2<NT){WAIT_BAR(1);} else {WAIT_BAR(0);} }while(0)
  for(;t+1<NT;t+=2){
    STEP(pB0,pB1,pA0,pA1,t,(t+3<NT),(t+1<NT),(t+1<NT));       ENDW(t);   RESC(); ROT();
    STEP(pA0,pA1,pB0,pB1,t+1,(t+4<NT),(t+2<NT),(t+2<NT));     ENDW(t+1); RESC(); ROT();
  }
  STEP(pB0,pB1,pA0,pA1,NT-1,false,false,false); RESC();
  { float sacc=pB0[0]+pB0[1]; _Pragma("unroll") for(int r=2;r<16;++r)sacc+=pB0[r]; _Pragma("unroll") for(int r=0;r<16;++r)sacc+=pB1[r]; l_reg+=sacc;
    pw0=(u32x4){PKW(pB0,0),PKW(pB0,2),PKW(pB0,4),PKW(pB0,6)};pw1=(u32x4){PKW(pB0,8),PKW(pB0,10),PKW(pB0,12),PKW(pB0,14)};pw2=(u32x4){PKW(pB1,0),PKW(pB1,2),PKW(pB1,4),PKW(pB1,6)};pw3=(u32x4){PKW(pB1,8),PKW(pB1,10),PKW(pB1,12),PKW(pB1,14)};
    SBAR(); pv(o,vb0+sl_cur,PAF(0),PAF(1),PAF(2),PAF(3)); }
  #undef PKW
  #undef PAF
  #undef VFR
  #undef PIN
  #undef MX3
  #undef GAPA
  #undef GAPB
  #undef EX
  #undef VRD
  #undef KRD
  #undef STEP
  #undef ENDW
  {auto rr=__builtin_amdgcn_permlane32_swap(__float_as_uint(l_reg),__float_as_uint(l_reg),false,false);l_reg=__uint_as_float(rr[0])+__uint_as_float(rr[1]);}
  if(hi==0)wsf[32+r32]=l_reg;asm volatile("s_waitcnt lgkmcnt(0)":::"memory");
  float rli[16];
  #pragma unroll
  for(int r=0;r<16;++r)rli[r]=__builtin_amdgcn_rcpf(wsf[32+crow(r,hi)]);
  bf16*Ow=Ou+(long)(wid*QBLK)*OP;
  { bf16*stg=(bf16*)(shm+LDS_OST)+wid*2048;
    #pragma unroll
    for(int r=0;r<16;++r){const int orow=crow(r,hi);
      #pragma unroll
      for(int d0=0;d0<2;++d0)stg[orow*64+d0*32+r32]=__float2bfloat16(o[d0][r]*rli[r]);}
    asm volatile("s_waitcnt lgkmcnt(0)":::"memory");
    #pragma unroll
    for(int i=0;i<4;++i){const int row=i*8+(lane>>3),ch=lane&7; const u32x4 v=*(const u32x4*)(stg+row*64+ch*8); ATTN_STORE16(Ow+(long)row*OP+ch*8,v);} }
  asm volatile("s_waitcnt lgkmcnt(0)\n\ts_barrier":::"memory");
  #undef NA_TOFF
  #undef NA_MASK
  #undef DMA_K
  #undef DMA_V
  #undef CMASK
  #undef START
  #undef RESC
  #undef ROT
}
#undef SBAR
#undef WAIT_BAR
}
#define LAS __attribute__((address_space(3)))
#define XB_TMO      128
#define XB_XCNT(j)  (256  + 64 * (j))
#define XB_XSUB(j)  (1280 + 64 * (j))
#define XB_XGEN(j)  (2304 + 64 * (j))
#define XB_TOP      3328
#define XB_TOPGEN   3392
#define XCD_BAR_WORDS 3456
#define XB_SPIN_CAP (1u << 18)

__device__ __forceinline__ unsigned xb_ld(unsigned* p)              { return __hip_atomic_load(p, __ATOMIC_RELAXED, __HIP_MEMORY_SCOPE_AGENT); }
__device__ __forceinline__ unsigned xb_add(unsigned* p, unsigned v) { return __hip_atomic_fetch_add(p, v, __ATOMIC_RELAXED, __HIP_MEMORY_SCOPE_AGENT); }
__device__ __forceinline__ unsigned xb_xcc_id() { return (unsigned)__builtin_amdgcn_s_getreg((3 << 11) | 20) & 0xFu; }
#define XB_SPIN(cond, bar) do { unsigned _sp = 0; while (cond) { __builtin_amdgcn_s_sleep(1); \
    if ((++_sp & 255u) == 0u) { if (xb_ld(&(bar)[XB_TMO])) break; if (_sp > XB_SPIN_CAP) { atomicAdd(&(bar)[XB_TMO], 1u); break; } } } } while (0)

struct XcdBarrier {
    unsigned* bar; unsigned x;
    volatile LAS unsigned* st;
};

__device__ __forceinline__ XcdBarrier xcd_barrier_post(unsigned* bar, volatile LAS unsigned* st) {
    XcdBarrier b; b.bar = bar; b.x = xb_xcc_id(); b.st = st;
    if (threadIdx.x == 0) (void)xb_add(&bar[XB_XCNT(b.x)], 1u);
    return b;
}
__device__ __forceinline__ void xcd_barrier_complete(unsigned* bar, unsigned x, unsigned& nloc, unsigned& nx) {
    const unsigned G = gridDim.x * gridDim.y * gridDim.z;
    unsigned sum, cnt, mine, sp = 0u;
    for (;;) {
        sum = 0u; cnt = 0u; mine = 0u;
#pragma unroll
        for (unsigned j = 0; j < 16; ++j) { const unsigned c = xb_ld(&bar[XB_XCNT(j)]); sum += c; cnt += (c > 0u) ? 1u : 0u; mine = (j == x) ? c : mine; }
        if (sum == G) break;
        __builtin_amdgcn_s_sleep(1);
        if ((++sp & 255u) == 0u) { if (xb_ld(&bar[XB_TMO])) break; if (sp > XB_SPIN_CAP) { atomicAdd(&bar[XB_TMO], 1u); break; } }
    }
    nloc = mine > 0u ? mine : 1u; nx = cnt > 0u ? cnt : 1u;
}

__device__ __forceinline__ void xcd_barrier(const XcdBarrier& b) {
    asm volatile("s_waitcnt vmcnt(0)" ::: "memory");
    __syncthreads();
    if (threadIdx.x == 0) {
        unsigned* bar = b.bar;
        __builtin_amdgcn_s_waitcnt(0);
        unsigned nloc = b.st[0], nx = b.st[1];
        if (nloc == 0u) { xcd_barrier_complete(bar, b.x, nloc, nx); b.st[0] = nloc; b.st[1] = nx; }
        const unsigned old = xb_add(&bar[XB_XSUB(b.x)], 1u);
        const unsigned gen = old / nloc;
        if (old + 1u == (gen + 1u) * nloc) {
            __builtin_amdgcn_fence(__ATOMIC_RELEASE, "agent");
            asm volatile("s_waitcnt vmcnt(0)" ::: "memory");
            const unsigned og = xb_add(&bar[XB_TOP], 1u);
            const unsigned tg = og / nx;
            if (og + 1u == (tg + 1u) * nx) xb_add(&bar[XB_TOPGEN], 1u);
            else XB_SPIN(xb_ld(&bar[XB_TOPGEN]) == tg, bar);
            __builtin_amdgcn_fence(__ATOMIC_ACQUIRE, "agent");
            xb_add(&bar[XB_XGEN(b.x)], 1u);
            asm volatile("s_waitcnt vmcnt(0)" ::: "memory");
        } else {
            XB_SPIN(xb_ld(&bar[XB_XGEN(b.x)]) == gen, bar);
            __builtin_amdgcn_fence(__ATOMIC_ACQUIRE, "agent");
            asm volatile("s_waitcnt vmcnt(0)" ::: "memory");
        }
    }
    __syncthreads();
}
typedef unsigned short bf16_t;
typedef float f32x4 __attribute__((ext_vector_type(4)));
typedef float f32x2 __attribute__((ext_vector_type(2)));
typedef unsigned u32x4 __attribute__((ext_vector_type(4)));
typedef unsigned u32x2 __attribute__((ext_vector_type(2)));
constexpr int NB = 4, SEQ = 4096, CTX = 256, DM = 2048, NLAT = NB * SEQ, NCTX = NB * CTX, NT = NLAT + NCTX;
constexpr int INP = 5120;
constexpr int KVLEN = SEQ + CTX;
constexpr float LOG2E = 1.4426950408889634f;
constexpr size_t MiB = 1u << 20;
constexpr size_t WS_CTL = 0, WS_MOD = 1 * MiB, WS_CTXR = 2 * MiB, WS_WIN = 10 * MiB, WS_WO0 = 30 * MiB, WS_W10 = 38 * MiB, WS_W20 = 70 * MiB,
                 WS_WQKV = 102 * MiB, WS_WO1 = 126 * MiB, WS_W11 = 134 * MiB, WS_W21 = 166 * MiB, WS_BP = 198 * MiB, WS_H = 204 * MiB,
                 WS_P = 272 * MiB, WS_XR = 442 * MiB, WS_XK = 476 * MiB, WS_XV = 510 * MiB, WS_KK = 544 * MiB, WS_AP = 578 * MiB,
                 WS_KALL = 595 * MiB, WS_VALL = 604 * MiB, WS_XRB = 613 * MiB  , WS_END = 677 * MiB;
constexpr size_t WS_ZB = 1 * MiB + 512 * 1024;
constexpr size_t WS_PART = 544 * MiB;
constexpr size_t WS_U = 272 * MiB;
constexpr size_t WS_Q1 = 272 * MiB, WS_K1 = 340 * MiB, WS_V1 = 408 * MiB, WS_O1 = 476 * MiB;
constexpr size_t DO_YF = 0, DO_YB = 34 * MiB, DO_Q0 = 68 * MiB;
constexpr int LDS_BYTES = 147456;

__device__ __forceinline__ float bf2f(bf16_t v) { return __uint_as_float((unsigned)v << 16); }
__device__ __forceinline__ unsigned f2bf(float f) { unsigned u = __float_as_uint(f); return (u + 0x7fffu + ((u >> 16) & 1u)) >> 16; }
__device__ __forceinline__ unsigned pk2(float lo, float hi) { return f2bf(lo) | (f2bf(hi) << 16); }
__device__ __forceinline__ float wave_sum(float v) {
#pragma unroll
    for (int o = 1; o < 64; o <<= 1) v += __shfl_xor(v, o);
    return v;
}
__device__ __forceinline__ float sigm(float x) { return 1.f / (1.f + __expf(-x)); }

struct Args {
    const float* in[39]; float* out; unsigned char* ws; int grid; int pad;
};


typedef __attribute__((address_space(4))) const Args KArgs;
__device__ __forceinline__ const float* kin(int i) { KArgs* k = (KArgs*)__builtin_amdgcn_kernarg_segment_ptr(); return *(const float* const volatile __attribute__((address_space(4)))*)&k->in[i]; }
__device__ __forceinline__ unsigned char* kws() { KArgs* k = (KArgs*)__builtin_amdgcn_kernarg_segment_ptr(); return *(unsigned char* const volatile __attribute__((address_space(4)))*)&k->ws; }
__device__ __forceinline__ float* kout() { KArgs* k = (KArgs*)__builtin_amdgcn_kernarg_segment_ptr(); return *(float* const volatile __attribute__((address_space(4)))*)&k->out; }
__device__ __forceinline__ void transpose_item(const float* W, int K, int N, bf16_t* WT, float* scr, int item, int lane) {
    const int nblk = N / 32, kb = item / nblk, nb = item % nblk, k0 = 64 * kb, n0 = 32 * nb;
    const int r = lane >> 3, c4 = lane & 7;
    f32x4 v[8];
#pragma unroll
    for (int i = 0; i < 8; ++i) v[i] = __builtin_nontemporal_load((const f32x4*)(W + (size_t)(k0 + 8 * i + r) * N + n0 + 4 * c4));
#pragma unroll
    for (int i = 0; i < 8; ++i) { float* d = scr + (8 * i + r) * 33 + 4 * c4; d[0] = v[i].x; d[1] = v[i].y; d[2] = v[i].z; d[3] = v[i].w; }
    __builtin_amdgcn_wave_barrier(); asm volatile("s_waitcnt lgkmcnt(0)" ::: "memory");
    const int c = lane & 7;
#pragma unroll
    for (int j = 0; j < 4; ++j) { const int n = (lane >> 3) + 8 * j; const float* s = scr + (8 * c) * 33 + n;
        u32x4 o; o.x = pk2(s[0 * 33], s[1 * 33]); o.y = pk2(s[2 * 33], s[3 * 33]); o.z = pk2(s[4 * 33], s[5 * 33]); o.w = pk2(s[6 * 33], s[7 * 33]);
        *(u32x4*)(WT + (size_t)(n0 + n) * K + k0 + 8 * c) = o; }
    __builtin_amdgcn_wave_barrier(); asm volatile("s_waitcnt lgkmcnt(0)" ::: "memory");
}

constexpr int TQ_ITEMS = 2 * (32 * 64) + 2 * (32 * 256) + 2 * (128 * 64) + 32 * 192;
__device__ __forceinline__ void transpose_deferred(int r, float* scr, int lane) {
    constexpr int I_O = 32 * 64, I_W1 = 32 * 256, I_W2 = 128 * 64, I_QKV = 32 * 192;
    if (r < I_O) { transpose_item(kin(26), 2048, 2048, (bf16_t*)(kws() + WS_WO0), scr, r, lane); return; } r -= I_O;
    if (r < I_W1) { transpose_item(kin(27), 2048, 8192, (bf16_t*)(kws() + WS_W10), scr, r, lane); return; } r -= I_W1;
    if (r < I_W2) { transpose_item(kin(28), 8192, 2048, (bf16_t*)(kws() + WS_W20), scr, r, lane); return; } r -= I_W2;
    if (r < I_QKV) { transpose_item(kin(33), 2048, 6144, (bf16_t*)(kws() + WS_WQKV), scr, r, lane); return; } r -= I_QKV;
    if (r < I_O) { transpose_item(kin(35), 2048, 2048, (bf16_t*)(kws() + WS_WO1), scr, r, lane); return; } r -= I_O;
    if (r < I_W1) { transpose_item(kin(36), 2048, 8192, (bf16_t*)(kws() + WS_W11), scr, r, lane); return; } r -= I_W1;
    transpose_item(kin(37), 8192, 2048, (bf16_t*)(kws() + WS_W21), scr, r, lane);
}
__device__ __forceinline__ void phase_prologue(unsigned char* shm) {
    const int tid = tidx(), lane = tid & 63, wid = tid >> 6, G = gridDim.x;
    float* st = (float*)(shm + 73728);
    float* red = (float*)(shm + 73728 + 40960);
    const float* cvec = kin(1); const float* cctx = kin(3);
    for (int i = tid; i < 5 * 2048; i += 512) { const int r = i >> 11, k = i & 2047; const float x = r < 4 ? cvec[r * 2048 + k] : cctx[k]; st[i] = x / (1.f + __expf(-x)); }
    __syncthreads();
    float* mod = (float*)(kws() + WS_MOD);
    for (int item = blockIdx.x; item < 768; item += G) {
        const int layer = item / 384, cch = item % 384, cl = tid & 31, kr = tid >> 5, col = cch * 32 + cl;
        const float* W = layer ? kin(31) : kin(6); const float* bias = layer ? kin(32) : kin(7);
        float acc[5] = {0.f, 0.f, 0.f, 0.f, 0.f};
#pragma unroll 32
        for (int i = 0; i < 128; ++i) { const int k = kr + 16 * i; const float w = __builtin_nontemporal_load(W + (size_t)k * 12288 + col);
#pragma unroll
            for (int r = 0; r < 5; ++r) acc[r] += st[r * 2048 + k] * w; }
#pragma unroll
        for (int r = 0; r < 5; ++r) red[(kr * 5 + r) * 32 + cl] = acc[r];
        __syncthreads();
        if (tid < 160) { const int r = tid >> 5; float s = 0.f;
#pragma unroll
            for (int q = 0; q < 16; ++q) s += red[(q * 5 + r) * 32 + cl];
            mod[(size_t)(layer * 5 + r) * 12288 + col] = s + bias[col]; }
        __syncthreads();
    }
    float* scr = (float*)(shm + wid * 8448);
    const int gw = blockIdx.x * 8 + wid, NGW = G * 8;
    for (int it = gw; it < 32 * 157; it += NGW) transpose_item(kin(8), 2048, 5024, (bf16_t*)(kws() + WS_WIN), scr, it, lane);
    const int gt = blockIdx.x * 512 + tid, GT = G * 512;
    { u32x4* z = (u32x4*)(kws() + WS_WIN + (size_t)5024 * 2048 * 2); for (int i = gt; i < 96 * 2048 * 2 / 16; i += GT) z[i] = (u32x4){0u, 0u, 0u, 0u}; }
    { float* ZB = (float*)(kws() + WS_ZB); for (int i = gt; i < 5120; i += GT) { const int blk = i >> 10, nn = i & 1023; ZB[i] = blk == 0 ? kin(10)[nn] : blk == 1 ? kin(11)[nn] : blk == 2 ? kin(14)[nn] : blk == 3 ? kin(15)[nn] : 0.f; } }
    { bf16_t* BP = (bf16_t*)(kws() + WS_BP);
      for (int i = gt; i < 5120 * 64; i += GT) { const int n = i % 5120, kc = i / 5120, blk = n >> 10, nn = n & 1023;
          const float* W = blk == 0 ? kin(12) : blk == 1 ? kin(13) : blk == 2 ? kin(16) : blk == 3 ? kin(17) : kin(18);
          const int klo = blk * 64, khi = blk == 4 ? 416 : klo + 64; float v[8];
#pragma unroll
          for (int e = 0; e < 8; ++e) { const int k = kc * 8 + e; v[e] = (k >= klo && k < khi) ? W[(size_t)(k - klo) * 1024 + nn] : 0.f; }
          u32x4 o; o.x = pk2(v[0], v[1]); o.y = pk2(v[2], v[3]); o.z = pk2(v[4], v[5]); o.w = pk2(v[6], v[7]);
          *(u32x4*)(BP + (size_t)n * 512 + kc * 8) = o; } }
}

__device__ __forceinline__ void phase_norm_mod(const float* srcL, const float* srcC, const float* g, const float* mod_sh, const float* mod_sc, bf16_t* dst, int nrows, const float* part = nullptr, const float* pgate = nullptr, const bf16_t* srcLb = nullptr) {
    const int tid = tidx(), lane = tid & 63, wid = tid >> 6; const int gw = blockIdx.x * 8 + wid, NGW = gridDim.x * 8;
    for (int row = gw; row < nrows; row += NGW) {
        const bool isc = row >= NLAT; const float* src = isc ? srcC + (size_t)(row - NLAT) * DM : srcL + (size_t)row * DM; const int ridx = isc ? 4 : (row >> 12);
        f32x4 v[8]; float s = 0.f;
#pragma unroll
        for (int j = 0; j < 8; ++j) {
            if (srcLb != nullptr && !isc) { const unsigned long long w = *(const unsigned long long*)(srcLb + (size_t)row * DM + j * 256 + lane * 4); const unsigned lo = (unsigned)w, hi = (unsigned)(w >> 32);
                v[j] = (f32x4){__uint_as_float(lo << 16), __uint_as_float(lo & 0xffff0000u), __uint_as_float(hi << 16), __uint_as_float(hi & 0xffff0000u)}; }
            else if (srcLb == nullptr && !isc) v[j] = __builtin_nontemporal_load((const f32x4*)(src + j * 256 + lane * 4));
            else v[j] = *(const f32x4*)(src + j * 256 + lane * 4);
            if (part != nullptr && isc) { const size_t po = (size_t)(row - NLAT) * DM + j * 256 + lane * 4; f32x4 ps = *(const f32x4*)(part + po);
#pragma unroll
                for (int p = 1; p < 8; ++p) ps = ps + *(const f32x4*)(part + (size_t)p * (1024 * 2048) + po);
                v[j] = v[j] + ps * *(const f32x4*)(pgate + 4 * 12288 + j * 256 + lane * 4); }
            s += (v[j].x * v[j].x + v[j].y * v[j].y) + (v[j].z * v[j].z + v[j].w * v[j].w); }
        const float rstd = rsqrtf(wave_sum(s) * (1.f / DM) + 1e-6f);
        const float* sh = mod_sh + (size_t)ridx * 12288; const float* sc = mod_sc + (size_t)ridx * 12288;
#pragma unroll
        for (int j = 0; j < 8; ++j) { const int c = j * 256 + lane * 4; const f32x4 gv = *(const f32x4*)(g + c), shv = *(const f32x4*)(sh + c), scv = *(const f32x4*)(sc + c);
            const f32x4 y = (v[j] * rstd) * gv; const f32x4 h = y * (scv + 1.f) + shv;
            u32x2 o; o.x = pk2(h.x, h.y); o.y = pk2(h.z, h.w); *(u32x2*)(dst + (size_t)row * DM + c) = o; }
    }
}
__device__ __forceinline__ void phase_final_norm(float* out, const float* g, int nrows, const bf16_t* xb) {
    const int tid = tidx(), lane = tid & 63, wid = tid >> 6; const int gw = blockIdx.x * 8 + wid, NGW = gridDim.x * 8;
    for (int row = gw; row < nrows; row += NGW) {
        const bf16_t* src = xb + (size_t)row * DM; float* dst = out + (size_t)row * DM; f32x4 v[8]; float s = 0.f;
#pragma unroll
        for (int j = 0; j < 8; ++j) { const unsigned long long w = __builtin_nontemporal_load((const unsigned long long*)(src + j * 256 + lane * 4)); const unsigned lo = (unsigned)w, hi = (unsigned)(w >> 32);
            v[j] = (f32x4){__uint_as_float(lo << 16), __uint_as_float(lo & 0xffff0000u), __uint_as_float(hi << 16), __uint_as_float(hi & 0xffff0000u)};
            s += (v[j].x * v[j].x + v[j].y * v[j].y) + (v[j].z * v[j].z + v[j].w * v[j].w); }
        const float rstd = rsqrtf(wave_sum(s) * (1.f / DM) + 1e-6f);
#pragma unroll
        for (int j = 0; j < 8; ++j) { const int c = j * 256 + lane * 4; const f32x4 gv = *(const f32x4*)(g + c); *(f32x4*)(dst + c) = (v[j] * rstd) * gv; }
    }
}

template <int CTRL> __device__ __forceinline__ float dppf(float x) { return __builtin_bit_cast(float, __builtin_amdgcn_mov_dpp(__builtin_bit_cast(int, x), CTRL, 0xf, 0xf, true)); }
__device__ __forceinline__ float red8(float x) { x += dppf<0xB1>(x); x += dppf<0x4E>(x); x += dppf<0x141>(x); return x; }
__device__ __forceinline__ void unpack8(const u32x4 v, float (&x)[8]) {
    x[0] = __uint_as_float(v.x << 16); x[1] = __uint_as_float(v.x & 0xffff0000u); x[2] = __uint_as_float(v.y << 16); x[3] = __uint_as_float(v.y & 0xffff0000u);
    x[4] = __uint_as_float(v.z << 16); x[5] = __uint_as_float(v.z & 0xffff0000u); x[6] = __uint_as_float(v.w << 16); x[7] = __uint_as_float(v.w & 0xffff0000u);
}
__device__ __forceinline__ u32x4 pack8(const float (&x)[8]) { u32x4 o; o.x = pk2(x[0], x[1]); o.y = pk2(x[2], x[3]); o.z = pk2(x[4], x[5]); o.w = pk2(x[6], x[7]); return o; }
__device__ __forceinline__ void phase_prep0() {
    const int tid = tidx(), lane = tid & 63, wid = tid >> 6, l7 = lane & 7; const int gw = blockIdx.x * 8 + wid, NGW = gridDim.x * 8;
    const bf16_t* P = (const bf16_t*)(kws() + WS_P);
    bf16_t* Q0 = (bf16_t*)((unsigned char*)kout() + DO_Q0); bf16_t* KALL = (bf16_t*)(kws() + WS_KALL); bf16_t* VALL = (bf16_t*)(kws() + WS_VALL);
    bf16_t* XR = (bf16_t*)(kws() + WS_XR); bf16_t* XK = (bf16_t*)(kws() + WS_XK); bf16_t* XV = (bf16_t*)(kws() + WS_XV); bf16_t* KK = (bf16_t*)(kws() + WS_KK); bf16_t* AP = (bf16_t*)(kws() + WS_AP);
    float muv[7][8], kkc[2][8], qn[8], kn[8];
    { const float* mu = kin(9); const float* k_k = kin(19); const float* qnp = kin(24); const float* knp = kin(25);
#pragma unroll
      for (int p = 0; p < 7; ++p)
#pragma unroll
          for (int e = 0; e < 8; ++e) { const int c = p * 512 + lane * 8 + e; muv[p][e] = c < 3488 ? mu[c] : 0.f; }
#pragma unroll
      for (int p = 0; p < 2; ++p)
#pragma unroll
          for (int e = 0; e < 8; ++e) kkc[p][e] = k_k[p * 512 + lane * 8 + e];
#pragma unroll
      for (int e = 0; e < 8; ++e) { qn[e] = qnp[l7 * 8 + e]; kn[e] = knp[l7 * 8 + e]; } }
    for (int row = gw; row < NT; row += NGW) {
        const bf16_t* prow = P + (size_t)row * INP;
        const bool isc = row >= NLAT; int b, t = 0, s = 0, grow = 0, gcol = 0;
        if (!isc) { b = row >> 12; t = row & 4095; grow = t >> 6; gcol = t & 63; } else { b = (row - NLAT) >> 8; s = (row - NLAT) & 255; }
        float cs[8], sn[8];
#pragma unroll
        for (int e = 0; e < 8; ++e) { cs[e] = 1.f; sn[e] = 0.f; }
        if (!isc) {
#pragma unroll
            for (int e = 0; e < 8; ++e) { const int i = 8 * (l7 & 3) + e, mm = i & 15; const float pos = (float)(i < 16 ? grow : gcol); const float ang = pos * exp2f(-(float)mm * 0.8304820237218406f); cs[e] = cosf(ang); sn[e] = sinf(ang); } }
        const int kvpos = isc ? SEQ + s : t;
#pragma unroll
        for (int p = 0; p < 3; ++p) {
            const u32x4 raw = *(const u32x4*)(prow + p * 512 + lane * 8); float x[8]; unpack8(raw, x);
            float ss = 0.f;
#pragma unroll
            for (int e = 0; e < 8; ++e) ss += x[e] * x[e];
            ss = red8(ss); const float rs = rsqrtf(ss * (1.f / 64.f) + 1e-6f);
            float y[8];
#pragma unroll
            for (int e = 0; e < 8; ++e) y[e] = x[e] * rs * (p < 2 ? qn[e] : kn[e]);
            if (!isc) {
#pragma unroll
                for (int e = 0; e < 8; ++e) { const float o = __shfl_xor(y[e], 4); y[e] = (l7 < 4) ? y[e] * cs[e] - o * sn[e] : y[e] * cs[e] + o * sn[e]; } }
            if (p < 2) {
#pragma unroll
                for (int e = 0; e < 8; ++e) y[e] *= 0.125f * LOG2E;
                *(u32x4*)(Q0 + (size_t)row * 1024 + p * 512 + lane * 8) = pack8(y);
            } else {
                const size_t kvo = ((size_t)(b * 4 + ((lane >> 3) & 3)) * KVLEN + kvpos) * 64 + l7 * 8;
                if (lane < 32) *(u32x4*)(KALL + kvo) = pack8(y);
                else *(u32x4*)(VALL + kvo) = raw;
            }
        }
        bool val[4]; const bf16_t* nrw[4];
        if (!isc) { val[0] = gcol > 0; val[1] = gcol < 63; val[2] = grow > 0; val[3] = grow < 63; nrw[0] = prow - INP; nrw[1] = prow + INP; nrw[2] = prow - 64 * INP; nrw[3] = prow + 64 * INP; }
        else { val[0] = val[2] = s > 0; val[1] = val[3] = s < 255; nrw[0] = nrw[2] = prow - INP; nrw[1] = nrw[3] = prow + INP; }
#pragma unroll
        for (int p = 0; p < 7; ++p) {
            const int c0 = 1536 + p * 512 + lane * 8;
            float cur[8], nb[4][8];
            unpack8(*(const u32x4*)(prow + c0), cur);
#pragma unroll
            for (int d = 0; d < 4; ++d) { u32x4 nv = (u32x4){0u, 0u, 0u, 0u}; if (val[d]) nv = *(const u32x4*)(nrw[d] + c0); unpack8(nv, nb[d]); }
            float xm[8];
#pragma unroll
            for (int e = 0; e < 8; ++e) xm[e] = cur[e] + muv[p][e] * (nb[e & 3][e] - cur[e]);
            if (p < 2) *(u32x4*)(XR + (size_t)row * 1024 + p * 512 + lane * 8) = pack8(xm);
            else if (p < 4) { *(u32x4*)(XK + (size_t)row * 1024 + (p - 2) * 512 + lane * 8) = pack8(xm);
                float t2[8]; float ss = 0.f;
#pragma unroll
                for (int e = 0; e < 8; ++e) { t2[e] = xm[e] * kkc[p - 2][e]; ss += t2[e] * t2[e]; }
                ss = red8(ss); const float rs = rsqrtf(fmaxf(ss, 1e-12f));
#pragma unroll
                for (int e = 0; e < 8; ++e) t2[e] *= rs;
                *(u32x4*)(KK + (size_t)row * 1024 + (p - 2) * 512 + lane * 8) = pack8(t2); }
            else if (p < 6) *(u32x4*)(XV + (size_t)row * 1024 + (p - 4) * 512 + lane * 8) = pack8(xm);
            else { float o[8]; const int a0 = lane * 8;
#pragma unroll
                for (int e = 0; e < 8; ++e) o[e] = a0 < 128 ? tanhf(xm[e]) : a0 < 256 ? xm[e] : a0 < 416 ? sigm(xm[e]) : 0.f;
                *(u32x4*)(AP + (size_t)row * 512 + a0) = pack8(o); }
        }
    }
}

__device__ __forceinline__ void phase_finish0() {
    const int tid = tidx(), lane = tid & 63, wid = tid >> 6; const int gw = blockIdx.x * 8 + wid, NGW = gridDim.x * 8;
    const bf16_t* YF = (const bf16_t*)((unsigned char*)kout() + DO_YF); const bf16_t* YB = (const bf16_t*)((unsigned char*)kout() + DO_YB);
    const bf16_t* XR = (const bf16_t*)(kws() + WS_XR); const bf16_t* XK = (const bf16_t*)(kws() + WS_XK); const bf16_t* XV = (const bf16_t*)(kws() + WS_XV);
    const bf16_t* Z = (const bf16_t*)(kws() + WS_P); bf16_t* OC = (bf16_t*)(kws() + WS_H);
    float kac[2][8], rkc[2][8], lgc[2][8], lbc[2][8];
    { const float* k_a = kin(20); const float* r_k = kin(21); const float* lg = kin(22); const float* lb = kin(23);
#pragma unroll
      for (int p = 0; p < 2; ++p)
#pragma unroll
          for (int e = 0; e < 8; ++e) { const int c = p * 512 + lane * 8 + e; kac[p][e] = k_a[c]; rkc[p][e] = r_k[c]; lgc[p][e] = lg[c]; lbc[p][e] = lb[c]; } }
    for (int row = gw; row < NT; row += NGW) {
#pragma unroll
        for (int p = 0; p < 2; ++p) { const int c0 = p * 512 + lane * 8; const size_t o = (size_t)row * 1024 + c0; const bf16_t* zr = Z + (size_t)row * INP + c0;
            float yf[8], yb[8], r[8], k[8], v[8], icf[8], icb[8], gt[8];
            unpack8(*(const u32x4*)(YF + o), yf); unpack8(*(const u32x4*)(YB + o), yb); unpack8(*(const u32x4*)(XR + o), r); unpack8(*(const u32x4*)(XK + o), k); unpack8(*(const u32x4*)(XV + o), v);
            unpack8(*(const u32x4*)(zr + 2048), icf); unpack8(*(const u32x4*)(zr + 3072), icb); unpack8(*(const u32x4*)(zr + 4096), gt);
            float y[8], sm = 0.f, bs = 0.f;
#pragma unroll
            for (int e = 0; e < 8; ++e) { y[e] = yf[e] + yb[e]; sm += y[e]; bs += r[e] * k[e] * (2.f + (icf[e] + icb[e] - 2.f) * kac[p][e]) * rkc[p][e]; }
            const float mean = red8(sm) * (1.f / 64.f); bs = red8(bs); float vs = 0.f;
#pragma unroll
            for (int e = 0; e < 8; ++e) { y[e] -= mean; vs += y[e] * y[e]; }
            const float rstd = rsqrtf(red8(vs) * (1.f / 64.f) + 64e-5f); float ov[8];
#pragma unroll
            for (int e = 0; e < 8; ++e) ov[e] = (y[e] * rstd * lgc[p][e] + lbc[p][e] + bs * v[e]) * gt[e];
            *(u32x4*)(OC + (size_t)row * 2048 + 1024 + c0) = pack8(ov); }
    }
}

__device__ __forceinline__ float allred8(float x) {
    x += dppf<0x128>(x);
    auto s = __builtin_amdgcn_permlane16_swap(__float_as_uint(x), __float_as_uint(x), false, false); x = __uint_as_float(s[0]) + __uint_as_float(s[1]);
    auto t = __builtin_amdgcn_permlane32_swap(__float_as_uint(x), __float_as_uint(x), false, false); return __uint_as_float(t[0]) + __uint_as_float(t[1]);
}
__device__ __forceinline__ float allred4(float x) {
    auto s = __builtin_amdgcn_permlane16_swap(__float_as_uint(x), __float_as_uint(x), false, false); x = __uint_as_float(s[0]) + __uint_as_float(s[1]);
    auto t = __builtin_amdgcn_permlane32_swap(__float_as_uint(x), __float_as_uint(x), false, false); return __uint_as_float(t[0]) + __uint_as_float(t[1]);
}
__device__ __forceinline__ void scan_block(unsigned char* shm, int sid, int half) {
    const int tid = tidx(), lane = tid & 63, wid = __builtin_amdgcn_readfirstlane(tid >> 6), nr = lane >> 4, g = lane & 15, rowl = wid * 4 + nr;
    const int dir = sid >> 6, b = (sid >> 4) & 3, h = sid & 15;
    const bf16_t* XR = (const bf16_t*)(kws() + WS_XR); const bf16_t* XK = (const bf16_t*)(kws() + WS_XK); const bf16_t* XV = (const bf16_t*)(kws() + WS_XV); const bf16_t* KK = (const bf16_t*)(kws() + WS_KK);
    const bf16_t* Z = (const bf16_t*)(kws() + WS_P);
    bf16_t* Y = (bf16_t*)((unsigned char*)kout() + (dir ? DO_YB : DO_YF));
    constexpr int TS = 32, NCH = (CTX + SEQ) / TS;
    float* bufs = (float*)shm;
    float* yst = (float*)(shm + 98304);
    const int ss = tid >> 4, part = tid & 15;
    float ka[4];
#pragma unroll
    for (int e = 0; e < 4; ++e) ka[e] = kin(20)[h * 64 + 4 * part + e];
    u32x2 lr, lk, lv, lkk, le, li;
#define SCAN_ROW(gs) ((gs) < CTX ? (NLAT + b * CTX + (dir ? CTX - 1 - (gs) : (gs))) : (b * SEQ + (dir ? SEQ - 1 - ((gs) - CTX) : ((gs) - CTX))))
#define SCAN_LOAD(c) do { const int row_ = SCAN_ROW((c) * TS + ss); const size_t o_ = (size_t)row_ * 1024 + h * 64 + 4 * part; const size_t z_ = (size_t)row_ * INP + dir * 1024 + h * 64 + 4 * part; \
        lr = *(const u32x2*)(XR + o_); lk = *(const u32x2*)(XK + o_); lv = *(const u32x2*)(XV + o_); lkk = *(const u32x2*)(KK + o_); le = *(const u32x2*)(Z + z_); li = *(const u32x2*)(Z + z_ + 2048); } while (0)
#define BFLO(u) __uint_as_float((u) << 16)
#define BFHI(u) __uint_as_float((u) & 0xffff0000u)
#define SCAN_STORE(c) do { float* bb_ = bufs + ((c) & 1) * 12288 + ss * 64 + 4 * part; \
        const f32x4 r_ = {BFLO(lr.x), BFHI(lr.x), BFLO(lr.y), BFHI(lr.y)}, k_ = {BFLO(lk.x), BFHI(lk.x), BFLO(lk.y), BFHI(lk.y)}, v_ = {BFLO(lv.x), BFHI(lv.x), BFLO(lv.y), BFHI(lv.y)}; \
        const f32x4 kk_ = {BFLO(lkk.x), BFHI(lkk.x), BFLO(lkk.y), BFHI(lkk.y)}, e_ = {BFLO(le.x), BFHI(le.x), BFLO(le.y), BFHI(le.y)}, i_ = {BFLO(li.x), BFHI(li.x), BFLO(li.y), BFHI(li.y)}; \
        const f32x4 kav_ = {ka[0], ka[1], ka[2], ka[3]}; \
        *(f32x4*)(bb_ + 0 * 2048) = 1.f - e_; *(f32x4*)(bb_ + 1 * 2048) = -kk_; *(f32x4*)(bb_ + 2 * 2048) = kk_ * i_; \
        *(f32x4*)(bb_ + 3 * 2048) = k_ * ((i_ - 1.f) * kav_ + 1.f); *(f32x4*)(bb_ + 4 * 2048) = r_; *(f32x4*)(bb_ + 5 * 2048) = v_; } while (0)
    SCAN_LOAD(0); SCAN_STORE(0);
    __syncthreads();
    float S[4] = {0.f, 0.f, 0.f, 0.f};
    for (int c = 0; c < NCH; ++c) {
        if (c + 1 < NCH) SCAN_LOAD(c + 1);
        { const float* bb = bufs + (c & 1) * 12288 + 4 * g; float* ys = yst + (c & 1) * 1024 + rowl; const float* vb = bufs + (c & 1) * 12288 + 5 * 2048 + half * 32 + rowl;
          f32x4 w4[3], a4[3], b4[3], k4[3], r4[3]; float vv[3];
#define LDOPS(s_) do { const float* p_ = bb + (s_) * 64; w4[(s_) % 3] = *(const f32x4*)(p_); a4[(s_) % 3] = *(const f32x4*)(p_ + 2048); b4[(s_) % 3] = *(const f32x4*)(p_ + 4096); k4[(s_) % 3] = *(const f32x4*)(p_ + 6144); \
              r4[(s_) % 3] = *(const f32x4*)(p_ + 8192); vv[(s_) % 3] = vb[(s_) * 64]; } while (0)
          LDOPS(0); LDOPS(1);
#pragma unroll
          for (int s = 0; s < TS; ++s) {
              const f32x4 a_ = a4[s % 3], w_ = w4[s % 3], b_ = b4[s % 3], k_ = k4[s % 3], r_ = r4[s % 3];
              const float av[4] = {a_.x, a_.y, a_.z, a_.w}, wv[4] = {w_.x, w_.y, w_.z, w_.w}, bv[4] = {b_.x, b_.y, b_.z, b_.w}, kv[4] = {k_.x, k_.y, k_.z, k_.w}, rv[4] = {r_.x, r_.y, r_.z, r_.w};
              const float v1 = vv[s % 3];
              if (s + 2 < TS) LDOPS(s + 2);
              float t = S[0] * av[0]; t = fmaf(S[1], av[1], t); t = fmaf(S[2], av[2], t); t = fmaf(S[3], av[3], t);
              t += dppf<0xB1>(t); t += dppf<0x4E>(t); t += dppf<0x141>(t); t += dppf<0x140>(t);
#pragma unroll
              for (int q = 0; q < 4; ++q) S[q] = fmaf(S[q], wv[q], fmaf(bv[q], t, kv[q] * v1));
              float u = S[0] * rv[0]; u = fmaf(S[1], rv[1], u); u = fmaf(S[2], rv[2], u); u = fmaf(S[3], rv[3], u);
              u += dppf<0xB1>(u); u += dppf<0x4E>(u); u += dppf<0x141>(u); u += dppf<0x140>(u);
              ys[s * 32] = u;
          }
#undef LDOPS
        }
        if (c + 1 < NCH) SCAN_STORE(c + 1);
        __syncthreads();
        { const f32x2 yv = *(const f32x2*)(yst + (c & 1) * 1024 + ss * 32 + 2 * part); const int row_ = SCAN_ROW(c * TS + ss);
          *(unsigned*)(Y + (size_t)row_ * 1024 + h * 64 + half * 32 + 2 * part) = pk2(yv.x, yv.y); }
    }
    __syncthreads();
#undef SCAN_ROW
#undef SCAN_LOAD
#undef SCAN_STORE
#undef BFLO
#undef BFHI
}

constexpr int AT_K = 0, AT_V = 16384, AT_WS = 32768, AT_OST = 34816, AT_RPB = 67584, AT_Q = 90112;
struct NaInfo { int i0, R0, nW; size_t latbase, ctxbase; };
template <int MODE> __device__ __forceinline__ void attn_unit(unsigned char* shmu, const bf16_t* Qw, int qpitch, const bf16_t* Kb, const bf16_t* Vb, int kvpitch, int ntiles,
                                                              bf16_t* Ow, int opitch, const NaInfo na) {
    using namespace att;
    char* shm = (char*)shmu;
    const int tid = tidx(), lane = tid & 63, r32 = lane & 31, hi = lane >> 5; const int wid = __builtin_amdgcn_readfirstlane(tid >> 6);
    bf16x8 qr[4];
#pragma unroll
    for (int d0 = 0; d0 < 4; ++d0) qr[d0] = *reinterpret_cast<const bf16x8*>(Qw + (size_t)r32 * qpitch + d0 * 16 + hi * 8);
    float* wsf = (float*)(shm + AT_WS) + wid * 64;
    const float* rpbs = (const float*)(shm + AT_RPB);
    const unsigned lds0 = (unsigned)(uintptr_t)shm;
    const int vb0 = (int)(lds0 + AT_V) + ((lane >> 4) & 1) * 32 + (lane & 3) * 8 + (4 * hi + ((lane & 15) >> 2)) * 64;
    const int kkey = lane, kch = wid;
    const int vkey = 16 * (wid & 3) + (lane >> 2), vd = (wid >> 2) * 32 + (lane & 3) * 8;
    const int sdst = wid * 1024 + lane * 16;
#define AT_ROWOFF(t) (MODE == 0 ? (size_t)(t) * 64 : ((t) < na.nW ? na.latbase + (size_t)(na.R0 + (t)) * 64 : na.ctxbase + (size_t)((t) - na.nW) * 64))
    u32x4 kreg, vreg;
    { const size_t ro = AT_ROWOFF(0); kreg = *(const u32x4*)(Kb + (ro + kkey) * kvpitch + kch * 8); vreg = *(const u32x4*)(Vb + (ro + vkey) * kvpitch + vd); }
    *(u32x4*)(shm + AT_K + sdst) = kreg; *(u32x4*)(shm + AT_V + sdst) = vreg;
    __syncthreads();
    float m_run = -1e30f, l_run = 0.f; f32x16 o[2]; o[0] = f32x16{}; o[1] = f32x16{};
    const f32x16 zero16 = f32x16{};
    const int qi = na.i0 + (wid >> 1), qc = 32 * (wid & 1) + r32; const int rs = min(max(qi - 4, 0), 56), csn = min(max(qc - 8, 0), 48);
    for (int t = 0; t < ntiles; ++t) {
        if (t + 1 < ntiles) { const size_t ro = AT_ROWOFF(t + 1); kreg = *(const u32x4*)(Kb + (ro + kkey) * kvpitch + kch * 8); vreg = *(const u32x4*)(Vb + (ro + vkey) * kvpitch + vd); }
        bool rel = true; int krow = 0;
        if (MODE == 1 && t < na.nW) { krow = na.R0 + t; rel = (krow >= rs) && (krow <= rs + 7); }
        if (rel) {
            f32x16 p0, p1;
            qkt(p0, p1, shm + AT_K + (t & 1) * 8192, qr, zero16, r32, hi);
            if (MODE == 1 && t < na.nW) { const int dr = (krow - qi + 7) * 31 + 15 - qc;
#pragma unroll
                for (int r = 0; r < 16; ++r) { const int kc0 = crow(r, hi), kc1 = kc0 + 32;
                    const bool v0 = (kc0 >= csn) && (kc0 < csn + 16), v1 = (kc1 >= csn) && (kc1 < csn + 16);
                    const float b0 = rpbs[v0 ? dr + kc0 : 0], b1 = rpbs[v1 ? dr + kc1 : 0];
                    p0[r] = v0 ? p0[r] + b0 : -1e30f; p1[r] = v1 ? p1[r] + b1 : -1e30f; } }
            const float rm = rowmax(p0, p1);
            const float m_new = fmaxf(m_run, rm); const float alpha = __builtin_amdgcn_exp2f(m_run - m_new); m_run = m_new;
            float sacc = 0.f;
#pragma unroll
            for (int r = 0; r < 16; ++r) { p0[r] = __builtin_amdgcn_exp2f(p0[r] - m_new); p1[r] = __builtin_amdgcn_exp2f(p1[r] - m_new); sacc += p0[r] + p1[r]; }
            l_run = l_run * alpha + sacc;
            if (hi == 0) wsf[r32] = alpha;
            asm volatile("s_waitcnt lgkmcnt(0)" ::: "memory");
#pragma unroll
            for (int r = 0; r < 16; ++r) { const float f = wsf[crow(r, hi)]; o[0][r] *= f; o[1][r] *= f; }
            u32x4 pw0, pw1, pw2, pw3;
            pw0 = (u32x4){cvtpk_s(p0[0], p0[1]), cvtpk_s(p0[2], p0[3]), cvtpk_s(p0[4], p0[5]), cvtpk_s(p0[6], p0[7])};
            pw1 = (u32x4){cvtpk_s(p0[8], p0[9]), cvtpk_s(p0[10], p0[11]), cvtpk_s(p0[12], p0[13]), cvtpk_s(p0[14], p0[15])};
            pw2 = (u32x4){cvtpk_s(p1[0], p1[1]), cvtpk_s(p1[2], p1[3]), cvtpk_s(p1[4], p1[5]), cvtpk_s(p1[6], p1[7])};
            pw3 = (u32x4){cvtpk_s(p1[8], p1[9]), cvtpk_s(p1[10], p1[11]), cvtpk_s(p1[12], p1[13]), cvtpk_s(p1[14], p1[15])};
            pv(o, vb0 + (t & 1) * 8192, __builtin_bit_cast(bf16x8, pw0), __builtin_bit_cast(bf16x8, pw1), __builtin_bit_cast(bf16x8, pw2), __builtin_bit_cast(bf16x8, pw3));
        }
        if (t + 1 < ntiles) { *(u32x4*)(shm + AT_K + ((t + 1) & 1) * 8192 + sdst) = kreg; *(u32x4*)(shm + AT_V + ((t + 1) & 1) * 8192 + sdst) = vreg; }
        __syncthreads();
    }
    { auto rr = __builtin_amdgcn_permlane32_swap(__float_as_uint(l_run), __float_as_uint(l_run), false, false); l_run = __uint_as_float(rr[0]) + __uint_as_float(rr[1]); }
    if (hi == 0) wsf[32 + r32] = l_run;
    asm volatile("s_waitcnt lgkmcnt(0)" ::: "memory");
    float rli[16];
#pragma unroll
    for (int r = 0; r < 16; ++r) rli[r] = __builtin_amdgcn_rcpf(wsf[32 + crow(r, hi)]);
    { bf16_t* stg = (bf16_t*)(shm + AT_OST) + wid * 2048;
#pragma unroll
      for (int r = 0; r < 16; ++r) { const int orow = crow(r, hi);
#pragma unroll
          for (int d0 = 0; d0 < 2; ++d0) stg[orow * 64 + d0 * 32 + r32] = (bf16_t)f2bf(o[d0][r] * rli[r]); }
      asm volatile("s_waitcnt lgkmcnt(0)" ::: "memory");
#pragma unroll
      for (int i = 0; i < 4; ++i) { const int row = i * 8 + (lane >> 3), ch = lane & 7; const u32x4 v = *(const u32x4*)(stg + row * 64 + ch * 8); *(u32x4*)(Ow + (size_t)row * opitch + ch * 8) = v; } }
    __syncthreads();
#undef AT_ROWOFF
}

__device__ __forceinline__ void phase_mix0(unsigned char* shm, int ctrw) {
#ifndef SCANREP
#define SCANREP 1
#endif
    for (int srep = 0; srep < SCANREP; ++srep)
    for (int hs = blockIdx.x; hs < 256; hs += gridDim.x) { const int x8 = hs & 7, slot = hs >> 3; scan_block(shm, (x8 >> 2) * 64 + (x8 & 3) * 16 + (slot >> 1), slot & 1); }
#ifndef QREP
#define QREP 1
#endif
    for (int qrep = 0; qrep < QREP; ++qrep) {
    unsigned* ctr = (unsigned*)(kws() + WS_CTL) + ctrw + 16 * qrep;
    const bf16_t* Q0 = (const bf16_t*)((unsigned char*)kout() + DO_Q0); const bf16_t* KALL = (const bf16_t*)(kws() + WS_KALL); const bf16_t* VALL = (const bf16_t*)(kws() + WS_VALL);
    bf16_t* OC = (bf16_t*)(kws() + WS_H);
    const int wid = tidx() >> 6; const NaInfo na{0, 0, 0, 0, 0};
    for (;;) {
        if (tidx() == 0) *(volatile unsigned*)(shm + AT_Q) = atomicAdd(ctr, 1u);
        __syncthreads();
        const unsigned u = *(volatile unsigned*)(shm + AT_Q);
        __syncthreads();
        if (u >= 1088u + (unsigned)(TQ_ITEMS / 64)) break;
        if (u >= 1088u) { const int base = (int)(u - 1088u) * 64; float* scr = (float*)(shm + wid * 8448); const int lane = tidx() & 63;
            for (int e = 0; e < 8; ++e) transpose_deferred(base + e * 8 + wid, scr, lane);
            __syncthreads(); continue; }
        if (u < 1024u) { const int b = u >> 8, hq = (u >> 4) & 15, qb = u & 15, kvh = hq >> 2; const size_t qrow = (size_t)b * SEQ + qb * 256 + wid * 32;
            att::attn_unit_p<8>((const att::bf16*)(Q0 + (qrow - wid * 32) * 1024 + hq * 64), 1024, (const att::bf16*)(KALL + (size_t)(b * 4 + kvh) * KVLEN * 64), (const att::bf16*)(VALL + (size_t)(b * 4 + kvh) * KVLEN * 64), 64, KVLEN / 64, (att::bf16*)(OC + (qrow - wid * 32) * 2048 + hq * 64), 2048, (char*)shm); }
        else { const int cu = u - 1024, b = cu >> 4, hq = cu & 15, kvh = hq >> 2; const size_t qrow = (size_t)NLAT + b * CTX + wid * 32;
            att::attn_unit_p<8>((const att::bf16*)(Q0 + (qrow - wid * 32) * 1024 + hq * 64), 1024, (const att::bf16*)(KALL + ((size_t)(b * 4 + kvh) * KVLEN + SEQ) * 64), (const att::bf16*)(VALL + ((size_t)(b * 4 + kvh) * KVLEN + SEQ) * 64), 64, CTX / 64, (att::bf16*)(OC + (qrow - wid * 32) * 2048 + hq * 64), 2048, (char*)shm); }
    }
    }
}
__device__ __forceinline__ void phase_mix1(unsigned char* shm) {
    const bf16_t* Q1 = (const bf16_t*)(kws() + WS_Q1); const bf16_t* K1 = (const bf16_t*)(kws() + WS_K1); const bf16_t* V1 = (const bf16_t*)(kws() + WS_V1); bf16_t* O1 = (bf16_t*)(kws() + WS_O1);
    const float* rpb = kin(34);
    float* rp = (float*)(shm + 86016);
    const bool fixed_head = gridDim.x == 256; int h_loaded = -1;
    for (int k = 0, u = blockIdx.x; u < 2048; ++k, u += gridDim.x) {
        int rb, h, b;
        if (fixed_head) { h = blockIdx.x & 31; const int rest = (blockIdx.x >> 5) + 8 * k; b = rest >> 4; rb = rest & 15; } else { rb = u & 15; h = (u >> 4) & 31; b = u >> 9; }
        const int i0 = rb * 4;
        if (h != h_loaded) { __syncthreads(); for (int i = tidx(); i < 465; i += 512) rp[i] = rpb[h * 465 + i] * LOG2E; h_loaded = h; }
        __syncthreads();
        att::NaP na; na.i0 = i0; na.R0 = min(max(i0 - 4, 0), 56); const int R1 = min(max(i0 + 3 - 4, 0), 56) + 7; na.nW = R1 - na.R0 + 1; na.rpbs = rp;
        const size_t latrow0 = (size_t)b * SEQ + (size_t)na.R0 * 64, ctxrow0 = (size_t)NLAT + b * CTX;
        na.jump = (long)ctxrow0 - (long)(latrow0 + (size_t)na.nW * 64);
        const int NTt = (na.nW + 4 + 1) & ~1;
        const size_t qrow = (size_t)b * SEQ + (size_t)i0 * 64;
        att::attn_unit_na<8>((const att::bf16*)(Q1 + qrow * 2048 + h * 64), 2048, (const att::bf16*)(K1 + latrow0 * 2048 + h * 64), (const att::bf16*)(V1 + latrow0 * 2048 + h * 64), 2048, NTt,
                             (att::bf16*)(O1 + qrow * 2048 + h * 64), 2048, (char*)shm, na);
        __syncthreads();
    }
}
__device__ __forceinline__ int opq(int v) { asm volatile("" : "+s"(v)); return v; }
#ifdef SYNC2
#define GSYNC() do { xcd_barrier(xbar); xcd_barrier(xbar); } while (0)
#else
#define GSYNC() xcd_barrier(xbar)
#endif
#ifndef DUPMASK
#define DUPMASK 0u
#endif
#define REP(k) for (int rep_ = 0; rep_ < 1 + (int)((DUPMASK >> (k)) & 1u); ++rep_)
__global__ void __launch_bounds__(512, 2) fwd_megakernel(Args a) {
    extern __shared__ __attribute__((aligned(16))) unsigned char lds[];
    cg::grid_group grid = cg::this_grid();
    { volatile LAS unsigned* st0 = (volatile LAS unsigned*)((LAS unsigned char*)lds + (LDS_BYTES - 64)); if (tidx() == 0) { st0[0] = 0u; st0[1] = 0u; } }
    __syncthreads();
    const XcdBarrier xbar = xcd_barrier_post((unsigned*)(kws() + WS_CTL) + 4096, (volatile LAS unsigned*)((LAS unsigned char*)lds + (LDS_BYTES - 64)));
#define G opq(gridDim.x)
#define c opq(blockIdx.x)
#define ws kws()
#define XIN kin(0)
#define CIN kin(2)
#define mod ((float*)(kws() + WS_MOD))
#define ctxr ((float*)(kws() + WS_CTXR))
#define H ((bf16_t*)(kws() + WS_H))
#define mod1 (mod + 5 * 12288)
    PG8_LAS unsigned char* glds = (PG8_LAS unsigned char*)lds;
    if (gridDim.y == 0x7fffu) grid.sync();
    REP(0) { phase_prologue(lds);
    GSYNC(); }
    REP(5) { phase_norm_mod(XIN, CIN, kin(4), mod + 0, mod + 2048, H, NT);
    GSYNC(); }
    { pg8::Gemm g{H, (const bf16_t*)(ws + WS_WIN), NT, INP, DM, DM}; pg8::StaticOrder S; S.init(NT, INP, G, c);
      pg8::EpiBf16<0> E{(bf16_t*)(ws + WS_P), INP, 0, 0, 1.f, nullptr};
      pg8::gemm_phase<pg8::EpiBf16<0>, pg8::StaticOrder, true, true>(glds, g, S, E); }
    GSYNC();
    REP(1) { phase_prep0();
    GSYNC(); }
    { pg8::Gemm g{(const bf16_t*)(ws + WS_AP), (const bf16_t*)(ws + WS_BP), NT, INP, 512, 256}; pg8::SliceOrder S; S.init(NT, INP, G, c); S.pn1 = 16;
      pg8::EpiBf16<3> E{(bf16_t*)(ws + WS_P), INP, 0, 0, 1.f, (const float*)(kws() + WS_ZB)};
      pg8::gemm_phase<pg8::EpiBf16<3>, pg8::SliceOrder, true, true>(glds, g, S, E); }
    GSYNC();
    REP(2) { phase_mix0(lds, 64 + 64 * rep_);
    GSYNC(); }
    REP(3) { phase_finish0();
    GSYNC(); }
    { pg8::Gemm g{H, (const bf16_t*)(ws + WS_WO0), NT, DM, DM, DM}; pg8::StaticOrder S; S.init(NT, DM, G, c);
      pg8::EpiResidB<false> E{XIN, (bf16_t*)(ws + WS_XRB), CIN, (bf16_t*)(ws + WS_XRB), ctxr, mod + 4096};
      pg8::gemm_phase<pg8::EpiResidB<false>, pg8::StaticOrder, true, true>(glds, g, S, E); }
    GSYNC();
    phase_norm_mod(kout(), ctxr, kin(5), mod + 6144, mod + 8192, H, NT, nullptr, nullptr, (bf16_t*)(ws + WS_XRB));
    GSYNC();
    REP(6)
    { pg8::Gemm g{H, (const bf16_t*)(ws + WS_W10), NT, 8192, DM, DM}; pg8::StaticOrder S; S.init(NT, 8192, G, c);
      pg8::EpiBf16<2> E{(bf16_t*)(ws + WS_U), 8192, 0, 0, 1.f, nullptr};
      pg8::gemm_phase<pg8::EpiBf16<2>, pg8::StaticOrder, true, true>(glds, g, S, E); }
    GSYNC();
    { pg8::Gemm g{(const bf16_t*)(ws + WS_U), (const bf16_t*)(ws + WS_W20), NLAT, DM, 8192, 8192}; pg8::StaticOrder S; S.init(NLAT, DM, G, c);
      pg8::EpiResidB<true> E{XIN, (bf16_t*)(ws + WS_XRB), ctxr, (bf16_t*)(ws + WS_XRB), ctxr, mod + 10240};
      pg8::gemm_phase<pg8::EpiResidB<true>, pg8::StaticOrder, true, true>(glds, g, S, E); }
    { pg8::Gemm g{(const bf16_t*)(ws + WS_U) + (size_t)NLAT * 8192, (const bf16_t*)(ws + WS_W20), NCTX, DM, 8192, 1024}; pg8::SplitOrder S; S.init(NCTX, DM, 8, G, c);
      pg8::EpiPartial E{(float*)(ws + WS_PART)};
      pg8::gemm_phase<pg8::EpiPartial, pg8::SplitOrder, true, true>(glds, g, S, E); }
    GSYNC();
    phase_norm_mod(kout(), ctxr, kin(29), mod1 + 0, mod1 + 2048, H, NT, (const float*)(ws + WS_PART), mod + 10240, (bf16_t*)(ws + WS_XRB));
    GSYNC();
    { pg8::Gemm g{H, (const bf16_t*)(ws + WS_WQKV), NT, 6144, DM, DM}; pg8::StaticOrder S; S.init(NT, 6144, G, c);
      pg8::EpiBf16<0> E{(bf16_t*)(ws + WS_Q1), 2048, 2048, (size_t)(WS_K1 - WS_Q1) / 2, 0.125f * LOG2E, nullptr};
      pg8::gemm_phase<pg8::EpiBf16<0>, pg8::StaticOrder, true, true>(glds, g, S, E); }
    GSYNC();
    REP(4) { phase_mix1(lds);
    GSYNC(); }
    { pg8::Gemm g{(const bf16_t*)(ws + WS_O1), (const bf16_t*)(ws + WS_WO1), NLAT, DM, DM, DM}; pg8::StaticOrder S; S.init(NLAT, DM, G, c);
      pg8::EpiResidB<true> E{XIN, (bf16_t*)(ws + WS_XRB), ctxr, (bf16_t*)(ws + WS_XRB), ctxr, mod1 + 4096};
      pg8::gemm_phase<pg8::EpiResidB<true>, pg8::StaticOrder, true, true>(glds, g, S, E); }
    GSYNC();
    phase_norm_mod(kout(), ctxr, kin(30), mod1 + 6144, mod1 + 8192, H, NLAT, nullptr, nullptr, (bf16_t*)(ws + WS_XRB));
    GSYNC();
    { pg8::Gemm g{H, (const bf16_t*)(ws + WS_W11), NLAT, 8192, DM, DM}; pg8::StaticOrder S; S.init(NLAT, 8192, G, c);
      pg8::EpiBf16<2> E{(bf16_t*)(ws + WS_U), 8192, 0, 0, 1.f, nullptr};
      pg8::gemm_phase<pg8::EpiBf16<2>, pg8::StaticOrder, true, true>(glds, g, S, E); }
    GSYNC();
    { pg8::Gemm g{(const bf16_t*)(ws + WS_U), (const bf16_t*)(ws + WS_W21), NLAT, DM, 8192, 8192}; pg8::StaticOrder S; S.init(NLAT, DM, G, c);
      pg8::EpiResidB<true> E{XIN, (bf16_t*)(ws + WS_XRB), ctxr, (bf16_t*)(ws + WS_XRB), ctxr, mod1 + 10240};
      pg8::gemm_phase<pg8::EpiResidB<true>, pg8::StaticOrder, true, true>(glds, g, S, E); }
    GSYNC();
    phase_final_norm(kout(), kin(38), NLAT, (bf16_t*)(ws + WS_XRB));
#undef G
#undef c
#undef ws
#undef XIN
#undef CIN
#undef mod
#undef ctxr
#undef H
#undef mod1
}

extern "C" void kernel_launch(void* const* d_in, const int* in_sizes, int n_in, void* d_out, int out_size, void* d_ws, size_t ws_size, hipStream_t stream) {
    static int grid = 0;
    if (grid == 0) {
        if (n_in != 39 || out_size != NLAT * DM || ws_size < WS_END) { fprintf(stderr, "kernel_launch: unexpected shapes (n_in %d out %d ws %zu)\n", n_in, out_size, ws_size); grid = -1; return; }
        int dev = 0, cus = 0, per = 0;
        (void)hipGetDevice(&dev); (void)hipDeviceGetAttribute(&cus, hipDeviceAttributeMultiprocessorCount, dev);
        (void)hipFuncSetAttribute((const void*)fwd_megakernel, hipFuncAttributeMaxDynamicSharedMemorySize, LDS_BYTES);
        (void)hipOccupancyMaxActiveBlocksPerMultiprocessor(&per, (const void*)fwd_megakernel, 512, LDS_BYTES);
        if (per < 1) per = 1;
        grid = cus * per;
        fprintf(stderr, "kernel_launch: grid %d (cus %d x %d), ws %zu\n", grid, cus, per, ws_size);
    }
    if (grid < 0) return;
    (void)hipMemsetAsync((char*)d_ws + WS_CTL, 0, 65536, stream);
    Args a{};
    for (int i = 0; i < 39; ++i) a.in[i] = (const float*)d_in[i];
    a.out = (float*)d_out; a.ws = (unsigned char*)d_ws; a.grid = grid; a.pad = 0;
    void* args[] = {&a};
    hipError_t e = hipLaunchCooperativeKernel((const void*)fwd_megakernel, dim3(grid), dim3(512), args, LDS_BYTES, stream);
    if (e != hipSuccess) fprintf(stderr, "kernel_launch: cooperative launch failed: %s (grid %d)\n", hipGetErrorString(e), grid);
}
```

```cpp
#include <hip/hip_runtime.h>
#include <hip/hip_bf16.h>
#include <hip/hip_cooperative_groups.h>
#include <cstdio>
#include <cstdint>
#include <cmath>
namespace cg = cooperative_groups;
namespace pg8 {
#define PG8_LAS __attribute__((address_space(3)))
typedef unsigned short bf16_t;
typedef short bf16x8 __attribute__((ext_vector_type(8)));
typedef float f32x4 __attribute__((ext_vector_type(4)));
typedef unsigned u32x4 __attribute__((ext_vector_type(4)));
constexpr int BM = 256, BK = 64, HALF = 128, HTB = HALF * BK * 2  , STAGE_BYTES = 8 * HTB, NXCD = 8, WGM = 8;

__host__ __device__ __forceinline__ int lds_byte(int r, int c) { const int st = (r >> 4) * 2 + (c >> 5), rr = r & 15, cc = c & 31, ob = rr * 64 + cc * 2; return st * 1024 + (ob ^ (((ob >> 9) & 1) << 5)); }
__host__ __device__ __forceinline__ void stage_rc(int b, int& R, int& C) { const int st = b / 1024, sb = b % 1024, swz = sb ^ (((sb >> 9) & 1) << 5); R = (st >> 1) * 16 + swz / 64; C = (st & 1) * 32 + (swz % 64) / 2; }
__host__ __device__ __forceinline__ int perm32(int rho) { const int n = rho >> 4, i = rho & 15; return 8 * (i >> 2) + 4 * n + (i & 3); }

struct Unit { int pm, pn, ks; };
struct Gemm { const bf16_t* A; const bf16_t* Bt; int M, N, K, Kc; };

struct StaticOrder {
    int nM, nN, nwg, G, c;
    __host__ __device__ void init(int M, int N, int G_, int c_) { nM = M / BM; nN = N / BM; nwg = nM * nN; G = G_; c = c_; }
    __host__ __device__ bool next(int i, Unit& u) const {
        const long L = (long)i * G + c; if (L >= nwg) return false;
        int wgid = (int)L; { const int q = nwg / NXCD, r = nwg % NXCD, xcd = wgid % NXCD, off = wgid / NXCD; wgid = (xcd < r ? xcd * (q + 1) : r * (q + 1) + (xcd - r) * q) + off; }
        const int nig = WGM * nN, gid = wgid / nig, fm = gid * WGM, gsz = (nM - fm) < WGM ? (nM - fm) : WGM;
        u.pm = fm + ((wgid % nig) % gsz); u.pn = (wgid % nig) / gsz; u.ks = 0; return true;
    }
    __device__ __forceinline__ void a_ready(const Unit&) const {}
    __device__ __forceinline__ void done(const Unit&) const {}
};

struct SplitOrder {
    int nM, nN, ksplit, total, G, c;
    __host__ __device__ void init(int M, int N, int ksplit_, int G_, int c_) { nM = M / BM; nN = N / BM; ksplit = ksplit_; total = nM * nN * ksplit; G = G_; c = c_; }
    __host__ __device__ bool next(int i, Unit& u) const { const long L = (long)i * G + c; if (L >= total) return false; const int t = (int)(L / ksplit); u.ks = (int)(L % ksplit); u.pn = t % nN; u.pm = t / nN; return true; }
    __device__ __forceinline__ void a_ready(const Unit&) const {}
    __device__ __forceinline__ void done(const Unit&) const {}
};
struct SliceOrder : StaticOrder {
    int pn1;
    __host__ __device__ bool next(int i, Unit& u) const { if (!StaticOrder::next(i, u)) return false; u.ks = u.pn >= pn1 ? 1 : 0; return true; }
};
__device__ __forceinline__ unsigned cvt_pk_bf16(float lo, float hi) { unsigned r; asm volatile("v_cvt_pk_bf16_f32 %0, %1, %2" : "=v"(r) : "v"(lo), "v"(hi)); return r; }
typedef float f32x2 __attribute__((ext_vector_type(2)));
template <int ACT> struct EpiBf16 {
    static constexpr bool PERM = true, AFTER_DRAIN = false;
    bf16_t* O; int ldc; int split_cols; size_t split_stride; float scale0; const float* zb;
    __device__ __forceinline__ void operator()(const f32x4 (&acc)[2][2][4][2], const Unit& u, int wr, int wc, int fr, int fq) const {
        const int row0 = u.pm * BM + wr * 64 + fr; int colt = u.pn * BM; bf16_t* base = O;
        float sc = 1.f; if (split_cols) { const int t = colt / split_cols; base += (size_t)t * split_stride; colt -= t * split_cols; if (t == 0) sc = scale0; }
        const int col0 = colt + wc * 32 + 8 * fq;
        int blk = 0; int cb = 0;
        if (ACT == 3) { blk = u.pn >> 2; cb = u.pn * BM + wc * 32 + 8 * fq; }
#pragma unroll
        for (int ai = 0; ai < 2; ++ai)
#pragma unroll
            for (int m = 0; m < 4; ++m) { bf16_t* rowp = base + (size_t)(row0 + ai * HALF + m * 16) * ldc + col0;
#pragma unroll
                for (int bj = 0; bj < 2; ++bj) { f32x4 v0 = acc[ai][bj][m][0], v1 = acc[ai][bj][m][1];
                    if (ACT == 2) {
#pragma unroll
                        for (int e = 0; e < 4; ++e) { float a = fmaxf(v0[e], 0.f), b = fmaxf(v1[e], 0.f); v0[e] = a * a; v1[e] = b * b; } }
                    if (ACT == 3) {
                        v0 = v0 + *(const f32x4*)(zb + cb + bj * HALF); v1 = v1 + *(const f32x4*)(zb + cb + bj * HALF + 4);
                        if (blk < 4) {
#pragma unroll
                            for (int e = 0; e < 4; ++e) { float s0 = 1.f / (1.f + __expf(-v0[e])), s1 = 1.f / (1.f + __expf(-v1[e]));
                                if (blk < 2) { s0 = 1.f - __expf(-0.60653066f * s0); s1 = 1.f - __expf(-0.60653066f * s1); }
                                v0[e] = s0; v1[e] = s1; } } }
                    v0 = v0 * sc; v1 = v1 * sc; u32x4 w; w.x = cvt_pk_bf16(v0[0], v0[1]); w.y = cvt_pk_bf16(v0[2], v0[3]); w.z = cvt_pk_bf16(v1[0], v1[1]); w.w = cvt_pk_bf16(v1[2], v1[3]);
                    *(u32x4*)(rowp + bj * HALF) = w; } }
    }
};
struct EpiResid {
    static constexpr bool PERM = false, AFTER_DRAIN = false;
    const float* baseL; const float* baseC; float* outL; float* outC; const float* gate;
    __device__ __forceinline__ void operator()(const f32x4 (&acc)[2][2][4][2], const Unit& u, int wr, int wc, int fr, int fq) const {
        const int trow = u.pm * BM; const bool isc = trow >= 16384; const int ridx = isc ? 4 : (trow >> 12);
        const float* g = gate + (size_t)ridx * 12288; const float* base = isc ? baseC : baseL; float* out = isc ? outC : outL;
        const int row0 = (isc ? trow - 16384 : trow) + wr * 64 + fr; const int col0 = u.pn * BM + wc * 32 + 4 * fq;
#pragma unroll
        for (int bj = 0; bj < 2; ++bj)
#pragma unroll
            for (int n = 0; n < 2; ++n) { const f32x4 gv = *(const f32x4*)(g + col0 + bj * HALF + n * 16);
#pragma unroll
                for (int ai = 0; ai < 2; ++ai)
#pragma unroll
                    for (int m = 0; m < 4; ++m) { const size_t off = (size_t)(row0 + ai * HALF + m * 16) * 2048 + col0 + bj * HALF + n * 16;
                        const f32x4 bs = *(const f32x4*)(base + off); *(f32x4*)(out + off) = bs + gv * acc[ai][bj][m][n]; } }
    }
};
struct EpiPartial {
    static constexpr bool PERM = true, AFTER_DRAIN = false;
    float* part;
    __device__ __forceinline__ void operator()(const f32x4 (&acc)[2][2][4][2], const Unit& u, int wr, int wc, int fr, int fq) const {
        float* out = part + (size_t)u.ks * (1024 * 2048); const int row0 = u.pm * BM + wr * 64 + fr; const int col0 = u.pn * BM + wc * 32 + 8 * fq;
#pragma unroll
        for (int bj = 0; bj < 2; ++bj)
#pragma unroll
            for (int ai = 0; ai < 2; ++ai)
#pragma unroll
                for (int m = 0; m < 4; ++m) { float* o = out + (size_t)(row0 + ai * HALF + m * 16) * 2048 + col0 + bj * HALF; *(f32x4*)(o) = acc[ai][bj][m][0]; *(f32x4*)(o + 4) = acc[ai][bj][m][1]; }
    }
};
template <bool BASE_BF16> struct EpiResidB {
    static constexpr bool PERM = true, AFTER_DRAIN = false;
    const float* baseLf; const bf16_t* baseLb; const float* baseC; bf16_t* outLb; float* outC; const float* gate;
    __device__ __forceinline__ void operator()(const f32x4 (&acc)[2][2][4][2], const Unit& u, int wr, int wc, int fr, int fq) const {
        const int trow = u.pm * BM; const bool isc = trow >= 16384; const int ridx = isc ? 4 : (trow >> 12);
        const float* g = gate + (size_t)ridx * 12288; const int row0 = (isc ? trow - 16384 : trow) + wr * 64 + fr; const int col0 = u.pn * BM + wc * 32 + 8 * fq;
#pragma unroll
        for (int bj = 0; bj < 2; ++bj) { const f32x4 g0 = *(const f32x4*)(g + col0 + bj * HALF), g1 = *(const f32x4*)(g + col0 + bj * HALF + 4);
#pragma unroll
            for (int ai = 0; ai < 2; ++ai)
#pragma unroll
                for (int m = 0; m < 4; ++m) { const size_t off = (size_t)(row0 + ai * HALF + m * 16) * 2048 + col0 + bj * HALF;
                    if (isc) { *(f32x4*)(outC + off) = *(const f32x4*)(baseC + off) + g0 * acc[ai][bj][m][0]; *(f32x4*)(outC + off + 4) = *(const f32x4*)(baseC + off + 4) + g1 * acc[ai][bj][m][1]; }
                    else { f32x4 b0, b1;
                        if (BASE_BF16) { const u32x4 w = *(const u32x4*)(baseLb + off);
                            b0 = (f32x4){__uint_as_float(w.x << 16), __uint_as_float(w.x & 0xffff0000u), __uint_as_float(w.y << 16), __uint_as_float(w.y & 0xffff0000u)};
                            b1 = (f32x4){__uint_as_float(w.z << 16), __uint_as_float(w.z & 0xffff0000u), __uint_as_float(w.w << 16), __uint_as_float(w.w & 0xffff0000u)}; }
                        else { b0 = *(const f32x4*)(baseLf + off); b1 = *(const f32x4*)(baseLf + off + 4); }
                        const f32x4 o0 = b0 + g0 * acc[ai][bj][m][0], o1 = b1 + g1 * acc[ai][bj][m][1];
                        u32x4 w; w.x = cvt_pk_bf16(o0[0], o0[1]); w.y = cvt_pk_bf16(o0[2], o0[3]); w.z = cvt_pk_bf16(o1[0], o1[1]); w.w = cvt_pk_bf16(o1[2], o1[3]);
                        *(u32x4*)(outLb + off) = w; } } }
    }
};
template <class Epi, class Sched, bool ALIGN_EPI = false, bool SP2 = false>
__device__ __forceinline__ void gemm_phase(PG8_LAS unsigned char* lds, const Gemm g, const Sched& S, const Epi& E) {
    int tid_ = threadIdx.x; asm volatile("" : "+v"(tid_)); const int tid = tid_, wid = __builtin_amdgcn_readfirstlane(tid >> 6), lane = tid & 63, wr = wid >> 2, wc = wid & 3, fr = lane & 15, fq = lane >> 4;
    const int K = g.K, nt = g.Kc / BK; const size_t kcb = (size_t)g.Kc * 2;
    unsigned voffA[2], voffB[2];
#pragma unroll
    for (int i = 0; i < 2; ++i) { int R, C; stage_rc(tid * 16 + i * 8192, R, C); const int Rb = Epi::PERM ? ((R & ~31) + perm32(R & 31)) : R;
        voffA[i] = (unsigned)(R * K + C) * 2u; voffB[i] = (unsigned)(Rb * K + C) * 2u; }
    const size_t kstep = (size_t)(BK * 2);
    const size_t hstep = (size_t)HALF * K * 2;
    const size_t tstep = 2 * hstep;
    const unsigned ldsw = (unsigned)wid * 1024u;
    const int aoff = lds_byte(wr * 64 + fr, fq * 8), boff = lds_byte(wc * 32 + fr, fq * 8);
#define PG8_SA(b, h) (((b) * 2 + (h)) * HTB)
#define PG8_SB(b, h) ((4 + (b) * 2 + (h)) * HTB)
#define PG8_STAGE(bufoff, gbase, voff) do { _Pragma("unroll") for (int _i = 0; _i < 2; ++_i) \
        __builtin_amdgcn_global_load_lds((const unsigned*)((const char*)(gbase) + (voff)[_i]), (PG8_LAS unsigned*)(lds + (bufoff) + ldsw + _i * 8192), 16, 0, 0); } while (0)
#define PG8_LDA(dst, b, h) do { _Pragma("unroll") for (int m = 0; m < 4; ++m) _Pragma("unroll") for (int k = 0; k < 2; ++k) dst[m][k] = *(const PG8_LAS bf16x8*)(lds + PG8_SA(b, h) + aoff + m * 2048 + k * 1024); } while (0)
#define PG8_LDB(dst, b, h) do { _Pragma("unroll") for (int n = 0; n < 2; ++n) _Pragma("unroll") for (int k = 0; k < 2; ++k) dst[n][k] = *(const PG8_LAS bf16x8*)(lds + PG8_SB(b, h) + boff + n * 2048 + k * 1024); } while (0)
#define PG8_MMA(ai, bj, At, Bt) do { __builtin_amdgcn_s_setprio(1); _Pragma("unroll") for (int m = 0; m < 4; ++m) _Pragma("unroll") for (int n = 0; n < 2; ++n) _Pragma("unroll") for (int k = 0; k < 2; ++k) \
        acc[ai][bj][m][n] = __builtin_amdgcn_mfma_f32_16x16x32_bf16(Bt[n][k], At[m][k], acc[ai][bj][m][n], 0, 0, 0); __builtin_amdgcn_s_setprio(0); } while (0)
#define PG8_WAIT_V(n) asm volatile("s_waitcnt vmcnt(" #n ")" ::: "memory")
#define PG8_WAIT_L(n) asm volatile("s_waitcnt lgkmcnt(" #n ")" ::: "memory")
#define PG8_BAR __builtin_amdgcn_s_barrier()
#define PG8_SCHED __builtin_amdgcn_sched_barrier(0)
    Unit cur, nxt; int ui = 0;
    if (!S.next(0, cur)) return;
    f32x4 acc[2][2][4][2];
#pragma unroll
    for (int a = 0; a < 2; ++a)
#pragma unroll
        for (int b = 0; b < 2; ++b)
#pragma unroll
            for (int m = 0; m < 4; ++m)
#pragma unroll
                for (int n = 0; n < 2; ++n) acc[a][b][m][n] = (f32x4){0.f, 0.f, 0.f, 0.f};
    bf16x8 At[4][2], B0[2][2], B1[2][2];
    const char* cA = (const char*)g.A + (size_t)cur.pm * tstep + (size_t)cur.ks * kcb; const char* cB = (const char*)g.Bt + (size_t)cur.pn * tstep + (size_t)cur.ks * kcb;
    S.a_ready(cur);
    if constexpr (SP2) {
        PG8_STAGE(PG8_SB(0, 0), cB, voffB); PG8_STAGE(PG8_SB(0, 1), cB + hstep, voffB); PG8_STAGE(PG8_SA(0, 0), cA, voffA); PG8_STAGE(PG8_SA(0, 1), cA + hstep, voffA);
        if (wr == 1) PG8_BAR;
        PG8_WAIT_V(2); PG8_BAR;
        PG8_STAGE(PG8_SB(1, 0), cB + kstep, voffB); PG8_STAGE(PG8_SA(1, 0), cA + kstep, voffA); PG8_STAGE(PG8_SB(1, 1), cB + hstep + kstep, voffB);
        PG8_WAIT_V(6); PG8_BAR;
    } else {
        PG8_STAGE(PG8_SB(0, 0), cB, voffB); PG8_STAGE(PG8_SA(0, 0), cA, voffA); PG8_STAGE(PG8_SB(0, 1), cB + hstep, voffB); PG8_STAGE(PG8_SA(0, 1), cA + hstep, voffA);
        if (wr == 1) PG8_BAR;
        PG8_WAIT_V(4); PG8_BAR;
        PG8_STAGE(PG8_SB(1, 0), cB + kstep, voffB); PG8_STAGE(PG8_SA(1, 0), cA + kstep, voffA); PG8_STAGE(PG8_SB(1, 1), cB + hstep + kstep, voffB);
        PG8_WAIT_V(6); PG8_BAR;
    }
    for (;;) {
        const bool has_next = S.next(ui + 1, nxt);
        const char* nA = has_next ? (const char*)g.A + (size_t)nxt.pm * tstep + (size_t)nxt.ks * kcb : cA; const char* nB = has_next ? (const char*)g.Bt + (size_t)nxt.pn * tstep + (size_t)nxt.ks * kcb : cB;
        for (int t = 0; t < nt; t += 2) {
            const bool last = (t == nt - 2);
            const char* a1 = cA + (size_t)(t + 1) * kstep;
            const char* a2 = last ? nA : cA + (size_t)(t + 2) * kstep; const char* b2 = last ? nB : cB + (size_t)(t + 2) * kstep;
            const char* a3 = a2 + kstep; const char* b3 = b2 + kstep;
            if (last && has_next) S.a_ready(nxt);
            if constexpr (SP2) {
            PG8_LDB(B0, 0, 0); PG8_LDB(B1, 0, 1); PG8_SCHED; PG8_LDA(At, 0, 0); PG8_STAGE(PG8_SA(1, 1), a1 + hstep, voffA);
            PG8_WAIT_V(8); PG8_WAIT_L(0); PG8_BAR; PG8_MMA(0, 0, At, B0); PG8_MMA(0, 1, At, B1); PG8_BAR; PG8_SCHED;
            PG8_LDA(At, 0, 1); PG8_STAGE(PG8_SB(0, 0), b2, voffB); PG8_STAGE(PG8_SB(0, 1), b2 + hstep, voffB); PG8_STAGE(PG8_SA(0, 0), a2, voffA);
            PG8_WAIT_V(8); PG8_WAIT_L(0); PG8_BAR; PG8_MMA(1, 0, At, B0); PG8_MMA(1, 1, At, B1); PG8_BAR; PG8_SCHED;
            PG8_LDB(B0, 1, 0); PG8_LDB(B1, 1, 1); PG8_SCHED; PG8_LDA(At, 1, 0); PG8_STAGE(PG8_SA(0, 1), a2 + hstep, voffA);
            PG8_WAIT_V(8); PG8_WAIT_L(0); PG8_BAR; PG8_MMA(0, 0, At, B0); PG8_MMA(0, 1, At, B1); PG8_BAR; PG8_SCHED;
            PG8_LDA(At, 1, 1); PG8_STAGE(PG8_SB(1, 0), b3, voffB); PG8_STAGE(PG8_SB(1, 1), b3 + hstep, voffB); PG8_STAGE(PG8_SA(1, 0), a3, voffA);
            PG8_WAIT_V(8); PG8_WAIT_L(0); PG8_BAR; PG8_MMA(1, 0, At, B0); PG8_MMA(1, 1, At, B1); PG8_BAR; PG8_SCHED;
            } else {
            PG8_LDB(B0, 0, 0); PG8_SCHED; PG8_LDA(At, 0, 0); PG8_STAGE(PG8_SA(1, 1), a1 + hstep, voffA);
            PG8_WAIT_L(8); PG8_BAR; PG8_WAIT_L(0); PG8_MMA(0, 0, At, B0); PG8_BAR; PG8_SCHED;
            PG8_LDB(B1, 0, 1); PG8_STAGE(PG8_SB(0, 0), b2, voffB);
            PG8_BAR; PG8_WAIT_L(0); PG8_MMA(0, 1, At, B1); PG8_BAR;
            PG8_LDA(At, 0, 1); PG8_STAGE(PG8_SA(0, 0), a2, voffA);
            PG8_BAR; PG8_WAIT_L(0); PG8_MMA(1, 0, At, B0); PG8_BAR; PG8_SCHED;
            PG8_STAGE(PG8_SB(0, 1), b2 + hstep, voffB);
            PG8_WAIT_V(6); PG8_BAR; PG8_MMA(1, 1, At, B1); PG8_BAR;
            PG8_LDB(B0, 1, 0); PG8_SCHED; PG8_LDA(At, 1, 0); PG8_STAGE(PG8_SA(0, 1), a2 + hstep, voffA);
            PG8_WAIT_L(8); PG8_BAR; PG8_WAIT_L(0); PG8_MMA(0, 0, At, B0); PG8_BAR; PG8_SCHED;
            PG8_LDB(B1, 1, 1); PG8_STAGE(PG8_SB(1, 0), b3, voffB);
            PG8_BAR; PG8_WAIT_L(0); PG8_MMA(0, 1, At, B1); PG8_BAR;
            PG8_LDA(At, 1, 1); PG8_STAGE(PG8_SA(1, 0), a3, voffA);
            PG8_BAR; PG8_WAIT_L(0); PG8_MMA(1, 0, At, B0); PG8_BAR; PG8_SCHED;
            PG8_STAGE(PG8_SB(1, 1), b3 + hstep, voffB);
            PG8_WAIT_V(6); PG8_BAR; PG8_MMA(1, 1, At, B1); PG8_BAR;
            }
        }
        if constexpr (ALIGN_EPI) { if (wr == 0) PG8_BAR; }
        if constexpr (!Epi::AFTER_DRAIN) { E(acc, cur, wr, wc, fr, fq); S.done(cur); }
        if (!has_next) break;
#pragma unroll
        for (int a = 0; a < 2; ++a)
#pragma unroll
            for (int b = 0; b < 2; ++b)
#pragma unroll
                for (int m = 0; m < 4; ++m)
#pragma unroll
                    for (int n = 0; n < 2; ++n) acc[a][b][m][n] = (f32x4){0.f, 0.f, 0.f, 0.f};
        cur = nxt; cA = nA; cB = nB; ++ui;
        if constexpr (ALIGN_EPI) { if (wr == 1) PG8_BAR; }
    }
    PG8_WAIT_V(0);
    if constexpr (!ALIGN_EPI) { if (wr == 0) PG8_BAR; }
    PG8_BAR;
    if constexpr (Epi::AFTER_DRAIN) { E.fused(acc, cur, wr, wc, fr, fq, lds, wid, lane); S.done(cur); }
#undef PG8_SA
#undef PG8_SB
#undef PG8_STAGE
#undef PG8_LDA
#undef PG8_LDB
#undef PG8_MMA
#undef PG8_WAIT_V
#undef PG8_WAIT_L
#undef PG8_BAR
#undef PG8_SCHED
}
}
__device__ __forceinline__ int tidx() { int t = threadIdx.x; asm volatile("" : "+v"(t)); return t; }
namespace att {
constexpr int NW=8,QBLK=32,KVBLK=64;
using bf16=__hip_bfloat16;
using bf16x8=__attribute__((ext_vector_type(8)))short;
using s16x4=__attribute__((ext_vector_type(4)))short;
using f32x16=__attribute__((ext_vector_type(16)))float;
using u32x4=__attribute__((ext_vector_type(4)))unsigned;
__device__ __forceinline__ int crow(int r,int hi){return (r&3)+8*(r>>2)+4*hi;}
#define SBAR() __builtin_amdgcn_sched_barrier(0)
__device__ __forceinline__ float max3f(float a,float b,float c){float r;asm("v_max3_f32 %0, %1, %2, %3":"=v"(r):"v"(a),"v"(b),"v"(c));return r;}
__device__ __forceinline__ float max2f(float a,float b){float r;asm("v_max_f32_e32 %0, %1, %2":"=v"(r):"v"(a),"v"(b));return r;}
__device__ __forceinline__ float fadd_s(float a,float b){float r;asm("v_add_f32_e32 %0, %1, %2":"=v"(r):"v"(a),"v"(b));return r;}
__device__ __forceinline__ float fsub_s(float a,float b){float r;asm("v_sub_f32_e32 %0, %1, %2":"=v"(r):"v"(a),"v"(b));return r;}
typedef float f32x2_t __attribute__((ext_vector_type(2))); typedef __bf16 bf16x2_t __attribute__((ext_vector_type(2)));
__device__ __forceinline__ unsigned cvtpk_s(float lo,float hi){f32x2_t v={lo,hi};bf16x2_t b=__builtin_convertvector(v,bf16x2_t);return __builtin_bit_cast(unsigned,b);}
__device__ __forceinline__ void qkt(f32x16&p0,f32x16&p1,const char*Kslot,const bf16x8*qr,const f32x16&negm,int r32,int hi){
  const char*kb=Kslot+hi*1024+r32*16;
  #pragma unroll
  for(int d0=0;d0<4;++d0){
    const bf16x8 b0=*reinterpret_cast<const bf16x8*>(kb+d0*2048);
    const bf16x8 b1=*reinterpret_cast<const bf16x8*>(kb+d0*2048+512);
    if(d0==0){p0=__builtin_amdgcn_mfma_f32_32x32x16_bf16(b0,qr[0],negm,0,0,0);p1=__builtin_amdgcn_mfma_f32_32x32x16_bf16(b1,qr[0],negm,0,0,0);}
    else{p0=__builtin_amdgcn_mfma_f32_32x32x16_bf16(b0,qr[d0],p0,0,0,0);p1=__builtin_amdgcn_mfma_f32_32x32x16_bf16(b1,qr[d0],p1,0,0,0);}}
}
__device__ __forceinline__ float rowmax(const f32x16&p0,const f32x16&p1){
  float a=max3f(p0[0],p0[1],p1[0]),b=max3f(p0[2],p0[3],p1[1]);a=max3f(a,p1[2],p1[3]);
  #pragma unroll
  for(int r=4;r<16;r+=4){a=max3f(a,p0[r],p0[r+1]);b=max3f(b,p0[r+2],p0[r+3]);a=max3f(a,p1[r],p1[r+1]);b=max3f(b,p1[r+2],p1[r+3]);}
  const float m=max2f(a,b);
  auto rr=__builtin_amdgcn_permlane32_swap(__float_as_uint(m),__float_as_uint(m),false,false);
  return max2f(__uint_as_float(rr[0]),__uint_as_float(rr[1]));
}
__device__ __forceinline__ void pv(f32x16*o,int vb,bf16x8 pa0,bf16x8 pa1,bf16x8 pa2,bf16x8 pa3){
  #pragma unroll
  for(int d0=0;d0<2;++d0){s16x4 lo[4],hi[4];
    #pragma unroll
    for(int ks=0;ks<4;++ks){
      asm volatile("ds_read_b64_tr_b16 %0,%1 offset:%c2":"=&v"(lo[ks]):"v"(vb),"i"(d0*4096+ks*1024):"memory");
      asm volatile("ds_read_b64_tr_b16 %0,%1 offset:%c2":"=&v"(hi[ks]):"v"(vb),"i"(d0*4096+ks*1024+512):"memory");}
    asm volatile("s_waitcnt lgkmcnt(0)":::"memory");SBAR();
    #define PK(k) (bf16x8){lo[k][0],lo[k][1],lo[k][2],lo[k][3],hi[k][0],hi[k][1],hi[k][2],hi[k][3]}
    o[d0]=__builtin_amdgcn_mfma_f32_32x32x16_bf16(pa0,PK(0),o[d0],0,0,0);
    o[d0]=__builtin_amdgcn_mfma_f32_32x32x16_bf16(pa1,PK(1),o[d0],0,0,0);
    o[d0]=__builtin_amdgcn_mfma_f32_32x32x16_bf16(pa2,PK(2),o[d0],0,0,0);
    o[d0]=__builtin_amdgcn_mfma_f32_32x32x16_bf16(pa3,PK(3),o[d0],0,0,0);
    #undef PK
  }
}
constexpr int NSLOT=3, SLOTB=8192;
constexpr int LDS_K=0, LDS_V=NSLOT*SLOTB, LDS_WS=2*NSLOT*SLOTB, LDS_OST=LDS_WS+NW*64*4, LDS_BYTES=LDS_OST+NW*4096;
constexpr float C2=0.125f*1.4426950408889634f;
__device__ __forceinline__ void glds16(const void*gsrc,unsigned lds_dst){unsigned keep;
  asm volatile("s_mov_b32 %0, m0\n\ts_mov_b32 m0, %2\n\ts_nop 0\n\tglobal_load_lds_dwordx4 %1, off\n\ts_mov_b32 m0, %0":"=&s"(keep):"v"(gsrc),"s"(lds_dst):"memory");}
#define WAIT_BAR(N) asm volatile("s_waitcnt vmcnt(" #N ") lgkmcnt(0)\n\ts_barrier":::"memory")
typedef __attribute__((address_space(3))) const char* lds_cptr;
typedef short v4i16_t __attribute__((ext_vector_type(4)));
__device__ __forceinline__ void kload8(bf16x8*kf,lds_cptr kp){
  kf[0]=*(const __attribute__((address_space(3))) bf16x8*)(kp);      kf[1]=*(const __attribute__((address_space(3))) bf16x8*)(kp+512);
  kf[2]=*(const __attribute__((address_space(3))) bf16x8*)(kp+2048); kf[3]=*(const __attribute__((address_space(3))) bf16x8*)(kp+2560);
  kf[4]=*(const __attribute__((address_space(3))) bf16x8*)(kp+4096); kf[5]=*(const __attribute__((address_space(3))) bf16x8*)(kp+4608);
  kf[6]=*(const __attribute__((address_space(3))) bf16x8*)(kp+6144); kf[7]=*(const __attribute__((address_space(3))) bf16x8*)(kp+6656);
}
__device__ __forceinline__ void kload2(bf16x8*kf,lds_cptr kp,int j){ kf[2*j]=*(const __attribute__((address_space(3))) bf16x8*)(kp+j*2048); kf[2*j+1]=*(const __attribute__((address_space(3))) bf16x8*)(kp+j*2048+512); }
__device__ __forceinline__ s16x4 vtr(lds_cptr p){ return __builtin_bit_cast(s16x4,__builtin_amdgcn_ds_read_tr16_b64_v4i16((__attribute__((address_space(3))) v4i16_t*)p)); }
#ifndef ATTN_STORE16
#define ATTN_STORE16(p,v) (*(u32x4*)(p)=(v))
#endif
template<int THRL> __device__ __forceinline__ void attn_unit_p(const bf16*Qu,int QP,const bf16*__restrict__ Kh,const bf16*__restrict__ Vh,int KP,int NT,bf16*Ou,int OP,char*shm){
  const int tid=tidx(),lane=tid&63,r32=lane&31,hi=lane>>5; const int wid=__builtin_amdgcn_readfirstlane(tid>>6);
  const bf16*Qw=Qu+(long)(wid*QBLK)*QP;
  const unsigned lds0=(unsigned)(uintptr_t)shm;
  float*wsf=(float*)(shm+LDS_WS)+wid*64;
  const bf16*ksrc=Kh+(long)lane*KP+wid*8;
  const bf16*vsrc=Vh+(long)(16*(wid&3)+(lane>>2))*KP+(wid>>2)*32+(lane&3)*8;
  const unsigned kdst=lds0+LDS_K+wid*1024, vdst=lds0+LDS_V+wid*1024;
  #define DMA_K(t,slot) glds16(ksrc+(long)(t)*KVBLK*KP,(unsigned)__builtin_amdgcn_readfirstlane(kdst+(slot)))
  #define DMA_V(t,slot) glds16(vsrc+(long)(t)*KVBLK*KP,(unsigned)__builtin_amdgcn_readfirstlane(vdst+(slot)))
  const int vb0=(int)(lds0+LDS_V)+((lane>>4)&1)*32+(lane&3)*8+(4*hi+((lane&15)>>2))*64;
  const char*Kbase=shm+LDS_K; bf16x8 kf[8];
  const lds_cptr shm3=(lds_cptr)shm; const lds_cptr kp0=shm3+LDS_K+hi*1024+r32*16; const lds_cptr vp0=shm3+LDS_V+((lane>>4)&1)*32+(lane&3)*8+(4*hi+((lane&15)>>2))*64;
  DMA_K(0,0);DMA_V(0,0);DMA_K(1,SLOTB);
  bf16x8 qr[4];
  #pragma unroll
  for(int d0=0;d0<4;++d0)qr[d0]=*reinterpret_cast<const bf16x8*>(&Qw[(long)r32*QP+d0*16+hi*8]);
  float mhat=0.f,l_reg=0.f;f32x16 o[2];o[0]=f32x16{};o[1]=f32x16{};f32x16 negm=f32x16{};asm volatile("":"+v"(negm));
  const int qrel=wid*QBLK+r32;
  #define CMASK(P0,P1,t) do{}while(0)
  bool resc=false;
  #define START(P0,P1) do{ const float rm=rowmax(P0,P1); resc=false; \
    { const float dl=rm; mhat=fadd_s(mhat,dl); \
      _Pragma("unroll") for(int r=0;r<16;++r){P0[r]=fsub_s(P0[r],dl);P1[r]=fsub_s(P1[r],dl);} \
      _Pragma("unroll") for(int r=0;r<16;++r)negm[r]=-mhat; asm volatile("":"+v"(negm)); } \
    _Pragma("unroll") for(int r=0;r<16;++r)P0[r]=__builtin_amdgcn_exp2f(P0[r]); }while(0)
  #define RESC() do{ if(resc){ asm volatile("s_waitcnt lgkmcnt(0)":::"memory"); \
      _Pragma("unroll") for(int d_=0;d_<2;++d_) _Pragma("unroll") for(int r=0;r<16;++r)o[d_][r]*=wsf[crow(r,hi)]; } }while(0)
  f32x16 pA0,pA1,pB0,pB1;
  int sl_prev=0,sl_cur=0,sl_next=SLOTB;
  #define ROT() do{sl_prev=sl_cur;sl_cur=sl_next;sl_next=(sl_next==(NSLOT-1)*SLOTB)?0:sl_next+SLOTB;}while(0)
  DMA_K(2,2*SLOTB);
  WAIT_BAR(3);
  qkt(pA0,pA1,Kbase,qr,negm,r32,hi);asm volatile("s_nop 15\n\ts_nop 7":"+v"(pA0),"+v"(pA1));CMASK(pA0,pA1,0);
  START(pA0,pA1);
  _Pragma("unroll") for(int r=0;r<16;++r)pA1[r]=__builtin_amdgcn_exp2f(pA1[r]);
  WAIT_BAR(0);
  DMA_K(3,0);DMA_V(1,SLOTB);
  ROT();
  kload8(kf,kp0+sl_cur);
  WAIT_BAR(2);
  s16x4 vlo[8],vhi[8]; u32x4 pw0,pw1,pw2,pw3;
  #define PKW(P,B) cvtpk_s(P[B],P[B+1])
  #define PAF(k) __builtin_bit_cast(bf16x8,pw##k)
  #define VFR(i) (bf16x8){vlo[i][0],vlo[i][1],vlo[i][2],vlo[i][3],vhi[i][0],vhi[i][1],vhi[i][2],vhi[i][3]}
  #define PIN(x) asm volatile("":"+v"(x))
  #define MX3(a,b,c) __builtin_fmaxf(__builtin_fmaxf((a),(b)),(c))
  #define GAPA(MF,A0,A1,A2,A3,W0,W1,PW) do{ MF; sacc+=A0; sacc+=A1; sacc+=A2; sacc+=A3; PIN(sacc); W0; W1; PIN(PW); SBAR(); }while(0)
  #define EX(v) __builtin_amdgcn_exp2f(v)
  #define GAPB(MF,X,B) do{ MF; X[B]=EX(X[B]); X[B+1]=EX(X[B+1]); X[B+2]=EX(X[B+2]); X[B+3]=EX(X[B+3]); PIN(X); SBAR(); }while(0)
  #define VRD(i) do{ vlo[i]=vtr(vp_+(((i)>>2)*4096+((i)&3)*1024)); vhi[i]=vtr(vp_+(((i)>>2)*4096+((i)&3)*1024+512)); }while(0)
  #define KRD(G,j) do{ if(G){ kload2(kf,kp0+sl_next,j); SBAR(); } }while(0)
  #define STEP(C0,C1,P0,P1,t,GK,GV,GL) do{ SBAR(); \
    const lds_cptr vp_=vp0+sl_prev; \
    VRD(0); SBAR(); float sacc=(P0[0]+P0[1]); \
    GAPA(C0=__builtin_amdgcn_mfma_f32_32x32x16_bf16(kf[0],qr[0],negm,0,0,0), P0[2],P0[3],P0[4],P0[5],     pw0[0]=PKW(P0,0), pw0[1]=PKW(P0,2), pw0); \
    VRD(4); SBAR(); GAPA(C1=__builtin_amdgcn_mfma_f32_32x32x16_bf16(kf[1],qr[0],negm,0,0,0), P0[6],P0[7],P0[8],P0[9],     pw0[2]=PKW(P0,4), pw0[3]=PKW(P0,6), pw0); \
    VRD(1); SBAR(); GAPA(C0=__builtin_amdgcn_mfma_f32_32x32x16_bf16(kf[2],qr[1],C0,0,0,0),   P0[10],P0[11],P0[12],P0[13], pw1[0]=PKW(P0,8), pw1[1]=PKW(P0,10), pw1); \
    VRD(5); SBAR(); GAPA(C1=__builtin_amdgcn_mfma_f32_32x32x16_bf16(kf[3],qr[1],C1,0,0,0),   P0[14],P0[15],P1[0],P1[1],   pw1[2]=PKW(P0,12),pw1[3]=PKW(P0,14), pw1); \
    VRD(2); SBAR(); GAPA(C0=__builtin_amdgcn_mfma_f32_32x32x16_bf16(kf[4],qr[2],C0,0,0,0),   P1[2],P1[3],P1[4],P1[5],     pw2[0]=PKW(P1,0), pw2[1]=PKW(P1,2), pw2); \
    VRD(6); SBAR(); GAPA(C1=__builtin_amdgcn_mfma_f32_32x32x16_bf16(kf[5],qr[2],C1,0,0,0),   P1[6],P1[7],P1[8],P1[9],     pw2[2]=PKW(P1,4), pw2[3]=PKW(P1,6), pw2); \
    VRD(3); SBAR(); GAPA(C0=__builtin_amdgcn_mfma_f32_32x32x16_bf16(kf[6],qr[3],C0,0,0,0),   P1[10],P1[11],P1[12],P1[13], pw3[0]=PKW(P1,8), pw3[1]=PKW(P1,10), pw3); \
    VRD(7); SBAR(); GAPA(C1=__builtin_amdgcn_mfma_f32_32x32x16_bf16(kf[7],qr[3],C1,0,0,0),   P1[14],P1[15],0.f,0.f,       pw3[2]=PKW(P1,12),pw3[3]=PKW(P1,14), pw3); \
    l_reg+=sacc; \
    if(GK){DMA_K((t)+3,sl_cur);} if(GV){DMA_V((t)+1,sl_next);} \
    CMASK(C0,C1,t); \
    { float a=MX3(C0[0],C0[1],C1[0]),b=MX3(C0[2],C0[3],C1[1]); a=MX3(a,C1[2],C1[3]); \
      _Pragma("unroll") for(int r=4;r<16;r+=4){a=MX3(a,C0[r],C0[r+1]);b=MX3(b,C0[r+2],C0[r+3]);a=MX3(a,C1[r],C1[r+1]);b=MX3(b,C1[r+2],C1[r+3]);} \
      float rm=__builtin_fmaxf(a,b); { auto rr=__builtin_amdgcn_permlane32_swap(__float_as_uint(rm),__float_as_uint(rm),false,false); rm=__builtin_fmaxf(__uint_as_float(rr[0]),__uint_as_float(rr[1])); } \
      resc=false; \
      if(__builtin_expect(__any(rm>(float)THRL),0)){ const float dl=__builtin_fmaxf(rm,0.f); mhat+=dl; \
        _Pragma("unroll") for(int r=0;r<16;++r){C0[r]-=dl;C1[r]-=dl;} \
        _Pragma("unroll") for(int r=0;r<16;++r)negm[r]=-mhat; asm volatile("":"+v"(negm)); \
        const float f=__builtin_amdgcn_exp2f(-dl); l_reg*=f; if(hi==0)wsf[r32]=f; resc=true; } } \
    SBAR(); \
    GAPB(o[0]=__builtin_amdgcn_mfma_f32_32x32x16_bf16(PAF(0),VFR(0),o[0],0,0,0), C0,0); \
    GAPB(o[1]=__builtin_amdgcn_mfma_f32_32x32x16_bf16(PAF(0),VFR(4),o[1],0,0,0), C0,4); \
    KRD(GL,0); GAPB(o[0]=__builtin_amdgcn_mfma_f32_32x32x16_bf16(PAF(1),VFR(1),o[0],0,0,0), C0,8); \
    KRD(GL,1); GAPB(o[1]=__builtin_amdgcn_mfma_f32_32x32x16_bf16(PAF(1),VFR(5),o[1],0,0,0), C0,12); \
    KRD(GL,2); GAPB(o[0]=__builtin_amdgcn_mfma_f32_32x32x16_bf16(PAF(2),VFR(2),o[0],0,0,0), C1,0); \
    KRD(GL,3); GAPB(o[1]=__builtin_amdgcn_mfma_f32_32x32x16_bf16(PAF(2),VFR(6),o[1],0,0,0), C1,4); \
    GAPB(o[0]=__builtin_amdgcn_mfma_f32_32x32x16_bf16(PAF(3),VFR(3),o[0],0,0,0), C1,8); \
    GAPB(o[1]=__builtin_amdgcn_mfma_f32_32x32x16_bf16(PAF(3),VFR(7),o[1],0,0,0), C1,12); \
    }while(0)
  int t=1;
  #undef CMASK
  #define CMASK(P0,P1,t) do{}while(0)
  for(;t+5<NT;t+=2){
    STEP(pB0,pB1,pA0,pA1,t,true,true,true);     WAIT_BAR(2); RESC(); ROT();
    STEP(pA0,pA1,pB0,pB1,t+1,true,true,true);   WAIT_BAR(2); RESC(); ROT();
  }
  #undef CMASK
  #define CMASK(P0,P1,t) do{}while(0)
  #define ENDW(tt) do{ if((tt)+3<NT){WAIT_BAR(2);} else if((tt)+2<NT){WAIT_BAR(1);} else {WAIT_BAR(0);} }while(0)
  for(;t+1<NT;t+=2){
    STEP(pB0,pB1,pA0,pA1,t,(t+3<NT),(t+1<NT),(t+1<NT));       ENDW(t);   RESC(); ROT();
    STEP(pA0,pA1,pB0,pB1,t+1,(t+4<NT),(t+2<NT),(t+2<NT));     ENDW(t+1); RESC(); ROT();
  }
  STEP(pB0,pB1,pA0,pA1,NT-1,false,false,false); RESC();
  { float sacc=pB0[0]+pB0[1]; _Pragma("unroll") for(int r=2;r<16;++r)sacc+=pB0[r]; _Pragma("unroll") for(int r=0;r<16;++r)sacc+=pB1[r]; l_reg+=sacc;
    pw0=(u32x4){PKW(pB0,0),PKW(pB0,2),PKW(pB0,4),PKW(pB0,6)};pw1=(u32x4){PKW(pB0,8),PKW(pB0,10),PKW(pB0,12),PKW(pB0,14)};pw2=(u32x4){PKW(pB1,0),PKW(pB1,2),PKW(pB1,4),PKW(pB1,6)};pw3=(u32x4){PKW(pB1,8),PKW(pB1,10),PKW(pB1,12),PKW(pB1,14)};
    SBAR(); pv(o,vb0+sl_cur,PAF(0),PAF(1),PAF(2),PAF(3)); }
  #undef PKW
  #undef PAF
  #undef VFR
  #undef PIN
  #undef MX3
  #undef GAPA
  #undef GAPB
  #undef EX
  #undef VRD
  #undef KRD
  #undef STEP
  #undef ENDW
  {auto rr=__builtin_amdgcn_permlane32_swap(__float_as_uint(l_reg),__float_as_uint(l_reg),false,false);l_reg=__uint_as_float(rr[0])+__uint_as_float(rr[1]);}
  if(hi==0)wsf[32+r32]=l_reg;asm volatile("s_waitcnt lgkmcnt(0)":::"memory");
  float rli[16];
  #pragma unroll
  for(int r=0;r<16;++r)rli[r]=__builtin_amdgcn_rcpf(wsf[32+crow(r,hi)]);
  bf16*Ow=Ou+(long)(wid*QBLK)*OP;
  { bf16*stg=(bf16*)(shm+LDS_OST)+wid*2048;
    #pragma unroll
    for(int r=0;r<16;++r){const int orow=crow(r,hi);
      #pragma unroll
      for(int d0=0;d0<2;++d0)stg[orow*64+d0*32+r32]=__float2bfloat16(o[d0][r]*rli[r]);}
    asm volatile("s_waitcnt lgkmcnt(0)":::"memory");
    #pragma unroll
    for(int i=0;i<4;++i){const int row=i*8+(lane>>3),ch=lane&7; const u32x4 v=*(const u32x4*)(stg+row*64+ch*8); ATTN_STORE16(Ow+(long)row*OP+ch*8,v);} }
  asm volatile("s_waitcnt lgkmcnt(0)\n\ts_barrier":::"memory");
  #undef DMA_K
  #undef DMA_V
  #undef CMASK
  #undef START
  #undef RESC
  #undef ROT
}
#ifndef ATTN_STORE16
#define ATTN_STORE16(p,v) (*(u32x4*)(p)=(v))
#endif
struct NaP { int nW, R0, i0; long jump; const float* rpbs; };
template<int THRL> __device__ __forceinline__ void attn_unit_na(const bf16*Qu,int QP,const bf16*__restrict__ Kh,const bf16*__restrict__ Vh,int KP,int NT,bf16*Ou,int OP,char*shm,const NaP na){
  const int tid=tidx(),lane=tid&63,r32=lane&31,hi=lane>>5; const int wid=__builtin_amdgcn_readfirstlane(tid>>6);
  const bf16*Qw=Qu+(long)(wid*QBLK)*QP;
  const unsigned lds0=(unsigned)(uintptr_t)shm;
  float*wsf=(float*)(shm+LDS_WS)+wid*64;
  const bf16*ksrc=Kh+(long)lane*KP+wid*8;
  const bf16*vsrc=Vh+(long)(16*(wid&3)+(lane>>2))*KP+(wid>>2)*32+(lane&3)*8;
  const unsigned kdst=lds0+LDS_K+wid*1024, vdst=lds0+LDS_V+wid*1024;
  #define NA_TOFF(t) ((long)((t)<na.nW+4?(t):na.nW+3)*KVBLK+((t)>=na.nW?na.jump:0L))
  const int na_qi=na.i0+(wid>>1), na_qc=32*(wid&1)+r32, na_rs=min(max(na_qi-4,0),56), na_cs=min(max(na_qc-8,0),48);
  #define NA_MASK(P0,P1,t) do{ const int t_=(t); if(t_<na.nW){ const int krow_=na.R0+t_; if(krow_<na_rs||krow_>na_rs+7){ _Pragma("unroll") for(int r=0;r<16;++r){P0[r]=-30000.f;P1[r]=-30000.f;} } \
      else { const int dr_=(krow_-na_qi+7)*31+15-na_qc; _Pragma("unroll") for(int r=0;r<16;++r){ const int k0_=crow(r,hi),k1_=k0_+32; const bool v0_=(k0_>=na_cs)&&(k0_<na_cs+16),v1_=(k1_>=na_cs)&&(k1_<na_cs+16); \
          const float b0_=na.rpbs[v0_?dr_+k0_:0],b1_=na.rpbs[v1_?dr_+k1_:0]; P0[r]=v0_?P0[r]+b0_:-30000.f; P1[r]=v1_?P1[r]+b1_:-30000.f; } } } \
    else if(t_>=na.nW+4){ _Pragma("unroll") for(int r=0;r<16;++r){P0[r]=-30000.f;P1[r]=-30000.f;} } }while(0)
  #define DMA_K(t,slot) glds16(ksrc+NA_TOFF(t)*KP,(unsigned)__builtin_amdgcn_readfirstlane(kdst+(slot)))
  #define DMA_V(t,slot) glds16(vsrc+NA_TOFF(t)*KP,(unsigned)__builtin_amdgcn_readfirstlane(vdst+(slot)))
  const int vb0=(int)(lds0+LDS_V)+((lane>>4)&1)*32+(lane&3)*8+(4*hi+((lane&15)>>2))*64;
  const char*Kbase=shm+LDS_K; bf16x8 kf[8];
  const lds_cptr shm3=(lds_cptr)shm; const lds_cptr kp0=shm3+LDS_K+hi*1024+r32*16; const lds_cptr vp0=shm3+LDS_V+((lane>>4)&1)*32+(lane&3)*8+(4*hi+((lane&15)>>2))*64;
  DMA_K(0,0);DMA_V(0,0);DMA_K(1,SLOTB);
  bf16x8 qr[4];
  #pragma unroll
  for(int d0=0;d0<4;++d0)qr[d0]=*reinterpret_cast<const bf16x8*>(&Qw[(long)r32*QP+d0*16+hi*8]);
  float mhat=0.f,l_reg=0.f;f32x16 o[2];o[0]=f32x16{};o[1]=f32x16{};
  const int qrel=wid*QBLK+r32;
  #define CMASK(P0,P1,t) NA_MASK(P0,P1,t)
  bool resc=false;
  #define START(P0,P1) do{ const float rm=rowmax(P0,P1); resc=false; \
    { const float dl=rm; mhat=fadd_s(mhat,dl); \
      _Pragma("unroll") for(int r=0;r<16;++r){P0[r]=fsub_s(P0[r],dl);P1[r]=fsub_s(P1[r],dl);} \
      } \
    _Pragma("unroll") for(int r=0;r<16;++r)P0[r]=__builtin_amdgcn_exp2f(P0[r]); }while(0)
  #define RESC() do{ if(resc){ asm volatile("s_waitcnt lgkmcnt(0)":::"memory"); \
      _Pragma("unroll") for(int d_=0;d_<2;++d_) _Pragma("unroll") for(int r=0;r<16;++r)o[d_][r]*=wsf[crow(r,hi)]; } }while(0)
  f32x16 pA0,pA1,pB0,pB1;
  int sl_prev=0,sl_cur=0,sl_next=SLOTB;
  #define ROT() do{sl_prev=sl_cur;sl_cur=sl_next;sl_next=(sl_next==(NSLOT-1)*SLOTB)?0:sl_next+SLOTB;}while(0)
  DMA_K(2,2*SLOTB);
  WAIT_BAR(3);
  qkt(pA0,pA1,Kbase,qr,f32x16{},r32,hi);asm volatile("s_nop 15\n\ts_nop 7":"+v"(pA0),"+v"(pA1));CMASK(pA0,pA1,0);
  START(pA0,pA1);
  _Pragma("unroll") for(int r=0;r<16;++r)pA1[r]=__builtin_amdgcn_exp2f(pA1[r]);
  WAIT_BAR(0);
  DMA_K(3,0);DMA_V(1,SLOTB);
  ROT();
  kload8(kf,kp0+sl_cur);
  WAIT_BAR(2);
  s16x4 vlo[8],vhi[8]; u32x4 pw0,pw1,pw2,pw3;
  #define PKW(P,B) cvtpk_s(P[B],P[B+1])
  #define PAF(k) __builtin_bit_cast(bf16x8,pw##k)
  #define VFR(i) (bf16x8){vlo[i][0],vlo[i][1],vlo[i][2],vlo[i][3],vhi[i][0],vhi[i][1],vhi[i][2],vhi[i][3]}
  #define PIN(x) asm volatile("":"+v"(x))
  #define MX3(a,b,c) __builtin_fmaxf(__builtin_fmaxf((a),(b)),(c))
  #define GAPA(MF,A0,A1,A2,A3,W0,W1,PW) do{ MF; sacc+=A0; sacc+=A1; sacc+=A2; sacc+=A3; PIN(sacc); W0; W1; PIN(PW); SBAR(); }while(0)
  #define EX(v) __builtin_amdgcn_exp2f(v)
  #define GAPB(MF,X,B) do{ MF; X[B]=EX(X[B]); X[B+1]=EX(X[B+1]); X[B+2]=EX(X[B+2]); X[B+3]=EX(X[B+3]); PIN(X); SBAR(); }while(0)
  #define VRD(i) do{ vlo[i]=vtr(vp_+(((i)>>2)*4096+((i)&3)*1024)); vhi[i]=vtr(vp_+(((i)>>2)*4096+((i)&3)*1024+512)); }while(0)
  #define KRD(G,j) do{ if(G){ kload2(kf,kp0+sl_next,j); SBAR(); } }while(0)
  #define STEP(C0,C1,P0,P1,t,GK,GV,GL) do{ SBAR(); \
    const lds_cptr vp_=vp0+sl_prev; \
    VRD(0); SBAR(); float sacc=(P0[0]+P0[1]); \
    GAPA(C0=__builtin_amdgcn_mfma_f32_32x32x16_bf16(kf[0],qr[0],f32x16{},0,0,0), P0[2],P0[3],P0[4],P0[5],     pw0[0]=PKW(P0,0), pw0[1]=PKW(P0,2), pw0); \
    VRD(4); SBAR(); GAPA(C1=__builtin_amdgcn_mfma_f32_32x32x16_bf16(kf[1],qr[0],f32x16{},0,0,0), P0[6],P0[7],P0[8],P0[9],     pw0[2]=PKW(P0,4), pw0[3]=PKW(P0,6), pw0); \
    VRD(1); SBAR(); GAPA(C0=__builtin_amdgcn_mfma_f32_32x32x16_bf16(kf[2],qr[1],C0,0,0,0),   P0[10],P0[11],P0[12],P0[13], pw1[0]=PKW(P0,8), pw1[1]=PKW(P0,10), pw1); \
    VRD(5); SBAR(); GAPA(C1=__builtin_amdgcn_mfma_f32_32x32x16_bf16(kf[3],qr[1],C1,0,0,0),   P0[14],P0[15],P1[0],P1[1],   pw1[2]=PKW(P0,12),pw1[3]=PKW(P0,14), pw1); \
    VRD(2); SBAR(); GAPA(C0=__builtin_amdgcn_mfma_f32_32x32x16_bf16(kf[4],qr[2],C0,0,0,0),   P1[2],P1[3],P1[4],P1[5],     pw2[0]=PKW(P1,0), pw2[1]=PKW(P1,2), pw2); \
    VRD(6); SBAR(); GAPA(C1=__builtin_amdgcn_mfma_f32_32x32x16_bf16(kf[5],qr[2],C1,0,0,0),   P1[6],P1[7],P1[8],P1[9],     pw2[2]=PKW(P1,4), pw2[3]=PKW(P1,6), pw2); \
    VRD(3); SBAR(); GAPA(C0=__builtin_amdgcn_mfma_f32_32x32x16_bf16(kf[6],qr[3],C0,0,0,0),   P1[10],P1[11],P1[12],P1[13], pw3[0]=PKW(P1,8), pw3[1]=PKW(P1,10), pw3); \
    VRD(7); SBAR(); GAPA(C1=__builtin_amdgcn_mfma_f32_32x32x16_bf16(kf[7],qr[3],C1,0,0,0),   P1[14],P1[15],0.f,0.f,       pw3[2]=PKW(P1,12),pw3[3]=PKW(P1,14), pw3); \
    l_reg+=sacc; \
    if(GK){DMA_K((t)+3,sl_cur);} if(GV){DMA_V((t)+1,sl_next);} \
    { const float mh_=mhat; _Pragma("unroll") for(int r=0;r<16;++r){C0[r]-=mh_;C1[r]-=mh_;} } \
    CMASK(C0,C1,t); \
    { float a=MX3(C0[0],C0[1],C1[0]),b=MX3(C0[2],C0[3],C1[1]); a=MX3(a,C1[2],C1[3]); \
      _Pragma("unroll") for(int r=4;r<16;r+=4){a=MX3(a,C0[r],C0[r+1]);b=MX3(b,C0[r+2],C0[r+3]);a=MX3(a,C1[r],C1[r+1]);b=MX3(b,C1[r+2],C1[r+3]);} \
      float rm=__builtin_fmaxf(a,b); { auto rr=__builtin_amdgcn_permlane32_swap(__float_as_uint(rm),__float_as_uint(rm),false,false); rm=__builtin_fmaxf(__uint_as_float(rr[0]),__uint_as_float(rr[1])); } \
      resc=false; \
      if(__builtin_expect(__any(rm>(float)THRL),0)){ const float dl=__builtin_fmaxf(rm,0.f); mhat+=dl; \
        _Pragma("unroll") for(int r=0;r<16;++r){C0[r]-=dl;C1[r]-=dl;} \
        const float f=__builtin_amdgcn_exp2f(-dl); l_reg*=f; if(hi==0)wsf[r32]=f; resc=true; } } \
    SBAR(); \
    GAPB(o[0]=__builtin_amdgcn_mfma_f32_32x32x16_bf16(PAF(0),VFR(0),o[0],0,0,0), C0,0); \
    GAPB(o[1]=__builtin_amdgcn_mfma_f32_32x32x16_bf16(PAF(0),VFR(4),o[1],0,0,0), C0,4); \
    KRD(GL,0); GAPB(o[0]=__builtin_amdgcn_mfma_f32_32x32x16_bf16(PAF(1),VFR(1),o[0],0,0,0), C0,8); \
    KRD(GL,1); GAPB(o[1]=__builtin_amdgcn_mfma_f32_32x32x16_bf16(PAF(1),VFR(5),o[1],0,0,0), C0,12); \
    KRD(GL,2); GAPB(o[0]=__builtin_amdgcn_mfma_f32_32x32x16_bf16(PAF(2),VFR(2),o[0],0,0,0), C1,0); \
    KRD(GL,3); GAPB(o[1]=__builtin_amdgcn_mfma_f32_32x32x16_bf16(PAF(2),VFR(6),o[1],0,0,0), C1,4); \
    GAPB(o[0]=__builtin_amdgcn_mfma_f32_32x32x16_bf16(PAF(3),VFR(3),o[0],0,0,0), C1,8); \
    GAPB(o[1]=__builtin_amdgcn_mfma_f32_32x32x16_bf16(PAF(3),VFR(7),o[1],0,0,0), C1,12); \
    }while(0)
  int t=1;
  #undef CMASK
  #define CMASK(P0,P1,t) NA_MASK(P0,P1,t)
  for(;t+5<NT;t+=2){
    STEP(pB0,pB1,pA0,pA1,t,true,true,true);     WAIT_BAR(2); RESC(); ROT();
    STEP(pA0,pA1,pB0,pB1,t+1,true,true,true);   WAIT_BAR(2); RESC(); ROT();
  }
  #undef CMASK
  #define CMASK(P0,P1,t) NA_MASK(P0,P1,t)
  #define ENDW(tt) do{ if((tt)+3<NT){WAIT_BAR(2);} else if((tt)+2<NT){WAIT_BAR(1);} else {WAIT_BAR(0);} }while(0)
  for(;t+1<NT;t+=2){
    STEP(pB0,pB1,pA0,pA1,t,(t+3<NT),(t+1<NT),(t+1<NT));       ENDW(t);   RESC(); ROT();
    STEP(pA0,pA1,pB0,pB1,t+1,(t+4<NT),(t+2<NT),(t+2<NT));     ENDW(t+1); RESC(); ROT();
  }
  STEP(pB0,pB1,pA0,pA1,NT-1,false,false,false); RESC();
  { float sacc=pB0[0]+pB0[1]; _Pragma("unroll") for(int r=2;r<16;++r)sacc+=pB0[r]; _Pragma("unroll") for(int r=0;r<16;++r)sacc+=pB1[r]; l_reg+=sacc;
    pw0=(u32x4){PKW(pB0,0),PKW(pB0,2),PKW(pB0,4),PKW(pB0,6)};pw1=(u32x4){PKW(pB0,8),PKW(pB0,10),PKW(pB0,12),PKW(pB0,14)};pw2=(u32x4){PKW(pB1,0),PKW(pB1,2),PKW(pB1,4),PKW(pB1,6)};pw3=(u32x4){PKW(pB1,8),PKW(pB1,10),PKW(pB1,12),PKW(pB1,14)};
    SBAR(); pv(o,vb0+sl_cur,PAF(0),PAF(1),PAF(2),PAF(3)); }
  #undef PKW
  #undef PAF
  #undef VFR
  #undef PIN
  #undef MX3
  #undef GAPA
  #undef GAPB
  #undef EX
  #undef VRD
  #undef KRD
  #undef STEP
  #undef ENDW
  {auto rr=__builtin_amdgcn_permlane32_swap(__float_as_uint(l_reg),__float_as_uint(l_reg),false,false);l_reg=__uint_as_float(rr[0])+__uint_as_float(rr[1]);}
  if(hi==0)wsf[32+r32]=l_reg;asm volatile("s_waitcnt lgkmcnt(0)":::"memory");
  float rli[16];
  #pragma unroll
  for(int r=0;r<16;++r)rli[r]=__builtin_amdgcn_rcpf(wsf[32+crow(r,hi)]);
  bf16*Ow=Ou+(long)(wid*QBLK)*OP;
  { bf16*stg=(bf16*)(shm+LDS_OST)+wid*2048;
    #pragma unroll
    for(int r=0;r<16;++r){const int orow=crow(r,hi);
      #pragma unroll
      for(int d0=0;d0<2;++d0)stg[orow*64+d0*32+r32]=__float2bfloat16(o[d0][r]*rli[r]);}
    asm volatile("s_waitcnt lgkmcnt(0)":::"memory");
    #pragma unroll
    for(int i=0;i<4;++i){const int row=i*8+(lane>>3),ch=lane&7; const u32x4 v=*(const u32x4*)(stg+row*64+ch*8); ATTN_STORE16(Ow+(long)row*OP+ch*8,v);} }
  asm volatile("s_waitcnt lgkmcnt(0)\n\ts_barrier":::"memory");
  #undef NA_TOFF
  #undef NA_MASK
  #undef DMA_K
  #undef DMA_V
  #undef CMASK
  #undef START
  #undef RESC
  #undef ROT
}
#undef SBAR
#undef WAIT_BAR
}
#define LAS __attribute__((address_space(3)))
#define XB_TMO      128
#define XB_XCNT(j)  (256  + 64 * (j))
#define XB_XSUB(j)  (1280 + 64 * (j))
#define XB_XGEN(j)  (2304 + 64 * (j))
#define XB_TOP      3328
#define XB_TOPGEN   3392
#define XCD_BAR_WORDS 3456
#define XB_SPIN_CAP (1u << 18)

__device__ __forceinline__ unsigned xb_ld(unsigned* p)              { return __hip_atomic_load(p, __ATOMIC_RELAXED, __HIP_MEMORY_SCOPE_AGENT); }
__device__ __forceinline__ unsigned xb_add(unsigned* p, unsigned v) { return __hip_atomic_fetch_add(p, v, __ATOMIC_RELAXED, __HIP_MEMORY_SCOPE_AGENT); }
__device__ __forceinline__ unsigned xb_xcc_id() { return (unsigned)__builtin_amdgcn_s_getreg((3 << 11) | 20) & 0xFu; }
#define XB_SPIN(cond, bar) do { unsigned _sp = 0; while (cond) { __builtin_amdgcn_s_sleep(1); \
    if ((++_sp & 255u) == 0u) { if (xb_ld(&(bar)[XB_TMO])) break; if (_sp > XB_SPIN_CAP) { atomicAdd(&(bar)[XB_TMO], 1u); break; } } } } while (0)

struct XcdBarrier {
    unsigned* bar; unsigned x;
    volatile LAS unsigned* st;
};

__device__ __forceinline__ XcdBarrier xcd_barrier_post(unsigned* bar, volatile LAS unsigned* st) {
    XcdBarrier b; b.bar = bar; b.x = xb_xcc_id(); b.st = st;
    if (threadIdx.x == 0) (void)xb_add(&bar[XB_XCNT(b.x)], 1u);
    return b;
}
__device__ __forceinline__ void xcd_barrier_complete(unsigned* bar, unsigned x, unsigned& nloc, unsigned& nx) {
    const unsigned G = gridDim.x * gridDim.y * gridDim.z;
    unsigned sum, cnt, mine, sp = 0u;
    for (;;) {
        sum = 0u; cnt = 0u; mine = 0u;
#pragma unroll
        for (unsigned j = 0; j < 16; ++j) { const unsigned c = xb_ld(&bar[XB_XCNT(j)]); sum += c; cnt += (c > 0u) ? 1u : 0u; mine = (j == x) ? c : mine; }
        if (sum == G) break;
        __builtin_amdgcn_s_sleep(1);
        if ((++sp & 255u) == 0u) { if (xb_ld(&bar[XB_TMO])) break; if (sp > XB_SPIN_CAP) { atomicAdd(&bar[XB_TMO], 1u); break; } }
    }
    nloc = mine > 0u ? mine : 1u; nx = cnt > 0u ? cnt : 1u;
}

__device__ __forceinline__ void xcd_barrier(const XcdBarrier& b) {
    asm volatile("s_waitcnt vmcnt(0)" ::: "memory");
    __syncthreads();
    if (threadIdx.x == 0) {
        unsigned* bar = b.bar;
        __builtin_amdgcn_s_waitcnt(0);
        unsigned nloc = b.st[0], nx = b.st[1];
        if (nloc == 0u) { xcd_barrier_complete(bar, b.x, nloc, nx); b.st[0] = nloc; b.st[1] = nx; }
        const unsigned old = xb_add(&bar[XB_XSUB(b.x)], 1u);
        const unsigned gen = old / nloc;
        if (old + 1u == (gen + 1u) * nloc) {
            __builtin_amdgcn_fence(__ATOMIC_RELEASE, "agent");
            asm volatile("s_waitcnt vmcnt(0)" ::: "memory");
            const unsigned og = xb_add(&bar[XB_TOP], 1u);
            const unsigned tg = og / nx;
            if (og + 1u == (tg + 1u) * nx) xb_add(&bar[XB_TOPGEN], 1u);
            else XB_SPIN(xb_ld(&bar[XB_TOPGEN]) == tg, bar);
            __builtin_amdgcn_fence(__ATOMIC_ACQUIRE, "agent");
            xb_add(&bar[XB_XGEN(b.x)], 1u);
            asm volatile("s_waitcnt vmcnt(0)" ::: "memory");
        } else {
            XB_SPIN(xb_ld(&bar[XB_XGEN(b.x)]) == gen, bar);
            __builtin_amdgcn_fence(__ATOMIC_ACQUIRE, "agent");
            asm volatile("s_waitcnt vmcnt(0)" ::: "memory");
        }
    }
    __syncthreads();
}
typedef unsigned short bf16_t;
typedef float f32x4 __attribute__((ext_vector_type(4)));
typedef float f32x2 __attribute__((ext_vector_type(2)));
typedef unsigned u32x4 __attribute__((ext_vector_type(4)));
typedef unsigned u32x2 __attribute__((ext_vector_type(2)));
constexpr int NB = 4, SEQ = 4096, CTX = 256, DM = 2048, NLAT = NB * SEQ, NCTX = NB * CTX, NT = NLAT + NCTX;
constexpr int INP = 5120;
constexpr int KVLEN = SEQ + CTX;
constexpr float LOG2E = 1.4426950408889634f;
constexpr size_t MiB = 1u << 20;
constexpr size_t WS_CTL = 0, WS_MOD = 1 * MiB, WS_CTXR = 2 * MiB, WS_WIN = 10 * MiB, WS_WO0 = 30 * MiB, WS_W10 = 38 * MiB, WS_W20 = 70 * MiB,
                 WS_WQKV = 102 * MiB, WS_WO1 = 126 * MiB, WS_W11 = 134 * MiB, WS_W21 = 166 * MiB, WS_BP = 198 * MiB, WS_H = 204 * MiB,
                 WS_P = 272 * MiB, WS_XR = 442 * MiB, WS_XK = 476 * MiB, WS_XV = 510 * MiB, WS_KK = 544 * MiB, WS_AP = 578 * MiB,
                 WS_KALL = 595 * MiB, WS_VALL = 604 * MiB, WS_XRB = 613 * MiB  , WS_END = 677 * MiB;
constexpr size_t WS_ZB = 1 * MiB + 512 * 1024;
constexpr size_t WS_PART = 544 * MiB;
constexpr size_t WS_U = 272 * MiB;
constexpr size_t WS_Q1 = 272 * MiB, WS_K1 = 340 * MiB, WS_V1 = 408 * MiB, WS_O1 = 476 * MiB;
constexpr size_t DO_YF = 0, DO_YB = 34 * MiB, DO_Q0 = 68 * MiB;
constexpr int LDS_BYTES = 147456;

__device__ __forceinline__ float bf2f(bf16_t v) { return __uint_as_float((unsigned)v << 16); }
__device__ __forceinline__ unsigned f2bf(float f) { unsigned u = __float_as_uint(f); return (u + 0x7fffu + ((u >> 16) & 1u)) >> 16; }
__device__ __forceinline__ unsigned pk2(float lo, float hi) { return f2bf(lo) | (f2bf(hi) << 16); }
__device__ __forceinline__ float wave_sum(float v) {
#pragma unroll
    for (int o = 1; o < 64; o <<= 1) v += __shfl_xor(v, o);
    return v;
}
__device__ __forceinline__ float sigm(float x) { return 1.f / (1.f + __expf(-x)); }

struct Args {
    const float* in[39]; float* out; unsigned char* ws; int grid; int pad;
};


typedef __attribute__((address_space(4))) const Args KArgs;
__device__ __forceinline__ const float* kin(int i) { KArgs* k = (KArgs*)__builtin_amdgcn_kernarg_segment_ptr(); return *(const float* const volatile __attribute__((address_space(4)))*)&k->in[i]; }
__device__ __forceinline__ unsigned char* kws() { KArgs* k = (KArgs*)__builtin_amdgcn_kernarg_segment_ptr(); return *(unsigned char* const volatile __attribute__((address_space(4)))*)&k->ws; }
__device__ __forceinline__ float* kout() { KArgs* k = (KArgs*)__builtin_amdgcn_kernarg_segment_ptr(); return *(float* const volatile __attribute__((address_space(4)))*)&k->out; }
__device__ __forceinline__ void transpose_item(const float* W, int K, int N, bf16_t* WT, float* scr, int item, int lane) {
    const int nblk = N / 32, kb = item / nblk, nb = item % nblk, k0 = 64 * kb, n0 = 32 * nb;
    const int r = lane >> 3, c4 = lane & 7;
    f32x4 v[8];
#pragma unroll
    for (int i = 0; i < 8; ++i) v[i] = __builtin_nontemporal_load((const f32x4*)(W + (size_t)(k0 + 8 * i + r) * N + n0 + 4 * c4));
#pragma unroll
    for (int i = 0; i < 8; ++i) { float* d = scr + (8 * i + r) * 33 + 4 * c4; d[0] = v[i].x; d[1] = v[i].y; d[2] = v[i].z; d[3] = v[i].w; }
    __builtin_amdgcn_wave_barrier(); asm volatile("s_waitcnt lgkmcnt(0)" ::: "memory");
    const int c = lane & 7;
#pragma unroll
    for (int j = 0; j < 4; ++j) { const int n = (lane >> 3) + 8 * j; const float* s = scr + (8 * c) * 33 + n;
        u32x4 o; o.x = pk2(s[0 * 33], s[1 * 33]); o.y = pk2(s[2 * 33], s[3 * 33]); o.z = pk2(s[4 * 33], s[5 * 33]); o.w = pk2(s[6 * 33], s[7 * 33]);
        *(u32x4*)(WT + (size_t)(n0 + n) * K + k0 + 8 * c) = o; }
    __builtin_amdgcn_wave_barrier(); asm volatile("s_waitcnt lgkmcnt(0)" ::: "memory");
}

constexpr int TQ_ITEMS = 2 * (32 * 64) + 2 * (32 * 256) + 2 * (128 * 64) + 32 * 192;
__device__ __forceinline__ void transpose_deferred(int r, float* scr, int lane) {
    constexpr int I_O = 32 * 64, I_W1 = 32 * 256, I_W2 = 128 * 64, I_QKV = 32 * 192;
    if (r < I_O) { transpose_item(kin(26), 2048, 2048, (bf16_t*)(kws() + WS_WO0), scr, r, lane); return; } r -= I_O;
    if (r < I_W1) { transpose_item(kin(27), 2048, 8192, (bf16_t*)(kws() + WS_W10), scr, r, lane); return; } r -= I_W1;
    if (r < I_W2) { transpose_item(kin(28), 8192, 2048, (bf16_t*)(kws() + WS_W20), scr, r, lane); return; } r -= I_W2;
    if (r < I_QKV) { transpose_item(kin(33), 2048, 6144, (bf16_t*)(kws() + WS_WQKV), scr, r, lane); return; } r -= I_QKV;
    if (r < I_O) { transpose_item(kin(35), 2048, 2048, (bf16_t*)(kws() + WS_WO1), scr, r, lane); return; } r -= I_O;
    if (r < I_W1) { transpose_item(kin(36), 2048, 8192, (bf16_t*)(kws() + WS_W11), scr, r, lane); return; } r -= I_W1;
    transpose_item(kin(37), 8192, 2048, (bf16_t*)(kws() + WS_W21), scr, r, lane);
}
__device__ __forceinline__ void phase_prologue(unsigned char* shm) {
    const int tid = tidx(), lane = tid & 63, wid = tid >> 6, G = gridDim.x;
    float* st = (float*)(shm + 73728);
    float* red = (float*)(shm + 73728 + 40960);
    const float* cvec = kin(1); const float* cctx = kin(3);
    for (int i = tid; i < 5 * 2048; i += 512) { const int r = i >> 11, k = i & 2047; const float x = r < 4 ? cvec[r * 2048 + k] : cctx[k]; st[i] = x / (1.f + __expf(-x)); }
    __syncthreads();
    float* mod = (float*)(kws() + WS_MOD);
    for (int item = blockIdx.x; item < 768; item += G) {
        const int layer = item / 384, cch = item % 384, cl = tid & 31, kr = tid >> 5, col = cch * 32 + cl;
        const float* W = layer ? kin(31) : kin(6); const float* bias = layer ? kin(32) : kin(7);
        float acc[5] = {0.f, 0.f, 0.f, 0.f, 0.f};
#pragma unroll 32
        for (int i = 0; i < 128; ++i) { const int k = kr + 16 * i; const float w = __builtin_nontemporal_load(W + (size_t)k * 12288 + col);
#pragma unroll
            for (int r = 0; r < 5; ++r) acc[r] += st[r * 2048 + k] * w; }
#pragma unroll
        for (int r = 0; r < 5; ++r) red[(kr * 5 + r) * 32 + cl] = acc[r];
        __syncthreads();
        if (tid < 160) { const int r = tid >> 5; float s = 0.f;
#pragma unroll
            for (int q = 0; q < 16; ++q) s += red[(q * 5 + r) * 32 + cl];
            mod[(size_t)(layer * 5 + r) * 12288 + col] = s + bias[col]; }
        __syncthreads();
    }
    float* scr = (float*)(shm + wid * 8448);
    const int gw = blockIdx.x * 8 + wid, NGW = G * 8;
    for (int it = gw; it < 32 * 157; it += NGW) transpose_item(kin(8), 2048, 5024, (bf16_t*)(kws() + WS_WIN), scr, it, lane);
    const int gt = blockIdx.x * 512 + tid, GT = G * 512;
    { u32x4* z = (u32x4*)(kws() + WS_WIN + (size_t)5024 * 2048 * 2); for (int i = gt; i < 96 * 2048 * 2 / 16; i += GT) z[i] = (u32x4){0u, 0u, 0u, 0u}; }
    { float* ZB = (float*)(kws() + WS_ZB); for (int i = gt; i < 5120; i += GT) { const int blk = i >> 10, nn = i & 1023; ZB[i] = blk == 0 ? kin(10)[nn] : blk == 1 ? kin(11)[nn] : blk == 2 ? kin(14)[nn] : blk == 3 ? kin(15)[nn] : 0.f; } }
    { bf16_t* BP = (bf16_t*)(kws() + WS_BP);
      for (int i = gt; i < 5120 * 64; i += GT) { const int n = i % 5120, kc = i / 5120, blk = n >> 10, nn = n & 1023;
          const float* W = blk == 0 ? kin(12) : blk == 1 ? kin(13) : blk == 2 ? kin(16) : blk == 3 ? kin(17) : kin(18);
          const int klo = blk * 64, khi = blk == 4 ? 416 : klo + 64; float v[8];
#pragma unroll
          for (int e = 0; e < 8; ++e) { const int k = kc * 8 + e; v[e] = (k >= klo && k < khi) ? W[(size_t)(k - klo) * 1024 + nn] : 0.f; }
          u32x4 o; o.x = pk2(v[0], v[1]); o.y = pk2(v[2], v[3]); o.z = pk2(v[4], v[5]); o.w = pk2(v[6], v[7]);
          *(u32x4*)(BP + (size_t)n * 512 + kc * 8) = o; } }
}

__device__ __forceinline__ void phase_norm_mod(const float* srcL, const float* srcC, const float* g, const float* mod_sh, const float* mod_sc, bf16_t* dst, int nrows, const float* part = nullptr, const float* pgate = nullptr, const bf16_t* srcLb = nullptr) {
    const int tid = tidx(), lane = tid & 63, wid = tid >> 6; const int gw = blockIdx.x * 8 + wid, NGW = gridDim.x * 8;
    for (int row = gw; row < nrows; row += NGW) {
        const bool isc = row >= NLAT; const float* src = isc ? srcC + (size_t)(row - NLAT) * DM : srcL + (size_t)row * DM; const int ridx = isc ? 4 : (row >> 12);
        f32x4 v[8]; float s = 0.f;
#pragma unroll
        for (int j = 0; j < 8; ++j) {
            if (srcLb != nullptr && !isc) { const unsigned long long w = *(const unsigned long long*)(srcLb + (size_t)row * DM + j * 256 + lane * 4); const unsigned lo = (unsigned)w, hi = (unsigned)(w >> 32);
                v[j] = (f32x4){__uint_as_float(lo << 16), __uint_as_float(lo & 0xffff0000u), __uint_as_float(hi << 16), __uint_as_float(hi & 0xffff0000u)}; }
            else if (srcLb == nullptr && !isc) v[j] = __builtin_nontemporal_load((const f32x4*)(src + j * 256 + lane * 4));
            else v[j] = *(const f32x4*)(src + j * 256 + lane * 4);
            if (part != nullptr && isc) { const size_t po = (size_t)(row - NLAT) * DM + j * 256 + lane * 4; f32x4 ps = *(const f32x4*)(part + po);
#pragma unroll
                for (int p = 1; p < 8; ++p) ps = ps + *(const f32x4*)(part + (size_t)p * (1024 * 2048) + po);
                v[j] = v[j] + ps * *(const f32x4*)(pgate + 4 * 12288 + j * 256 + lane * 4); }
            s += (v[j].x * v[j].x + v[j].y * v[j].y) + (v[j].z * v[j].z + v[j].w * v[j].w); }
        const float rstd = rsqrtf(wave_sum(s) * (1.f / DM) + 1e-6f);
        const float* sh = mod_sh + (size_t)ridx * 12288; const float* sc = mod_sc + (size_t)ridx * 12288;
#pragma unroll
        for (int j = 0; j < 8; ++j) { const int c = j * 256 + lane * 4; const f32x4 gv = *(const f32x4*)(g + c), shv = *(const f32x4*)(sh + c), scv = *(const f32x4*)(sc + c);
            const f32x4 y = (v[j] * rstd) * gv; const f32x4 h = y * (scv + 1.f) + shv;
            u32x2 o; o.x = pk2(h.x, h.y); o.y = pk2(h.z, h.w); *(u32x2*)(dst + (size_t)row * DM + c) = o; }
    }
}
__device__ __forceinline__ void phase_final_norm(float* out, const float* g, int nrows, const bf16_t* xb) {
    const int tid = tidx(), lane = tid & 63, wid = tid >> 6; const int gw = blockIdx.x * 8 + wid, NGW = gridDim.x * 8;
    for (int row = gw; row < nrows; row += NGW) {
        const bf16_t* src = xb + (size_t)row * DM; float* dst = out + (size_t)row * DM; f32x4 v[8]; float s = 0.f;
#pragma unroll
        for (int j = 0; j < 8; ++j) { const unsigned long long w = *(const unsigned long long*)(src + j * 256 + lane * 4); const unsigned lo = (unsigned)w, hi = (unsigned)(w >> 32);
            v[j] = (f32x4){__uint_as_float(lo << 16), __uint_as_float(lo & 0xffff0000u), __uint_as_float(hi << 16), __uint_as_float(hi & 0xffff0000u)};
            s += (v[j].x * v[j].x + v[j].y * v[j].y) + (v[j].z * v[j].z + v[j].w * v[j].w); }
        const float rstd = rsqrtf(wave_sum(s) * (1.f / DM) + 1e-6f);
#pragma unroll
        for (int j = 0; j < 8; ++j) { const int c = j * 256 + lane * 4; const f32x4 gv = *(const f32x4*)(g + c); *(f32x4*)(dst + c) = (v[j] * rstd) * gv; }
    }
}

template <int CTRL> __device__ __forceinline__ float dppf(float x) { return __builtin_bit_cast(float, __builtin_amdgcn_mov_dpp(__builtin_bit_cast(int, x), CTRL, 0xf, 0xf, true)); }
__device__ __forceinline__ float red8(float x) { x += dppf<0xB1>(x); x += dppf<0x4E>(x); x += dppf<0x141>(x); return x; }
__device__ __forceinline__ void unpack8(const u32x4 v, float (&x)[8]) {
    x[0] = __uint_as_float(v.x << 16); x[1] = __uint_as_float(v.x & 0xffff0000u); x[2] = __uint_as_float(v.y << 16); x[3] = __uint_as_float(v.y & 0xffff0000u);
    x[4] = __uint_as_float(v.z << 16); x[5] = __uint_as_float(v.z & 0xffff0000u); x[6] = __uint_as_float(v.w << 16); x[7] = __uint_as_float(v.w & 0xffff0000u);
}
__device__ __forceinline__ u32x4 pack8(const float (&x)[8]) { u32x4 o; o.x = pk2(x[0], x[1]); o.y = pk2(x[2], x[3]); o.z = pk2(x[4], x[5]); o.w = pk2(x[6], x[7]); return o; }
__device__ __forceinline__ void phase_prep0() {
    const int tid = tidx(), lane = tid & 63, wid = tid >> 6, l7 = lane & 7; const int gw = blockIdx.x * 8 + wid, NGW = gridDim.x * 8;
    const bf16_t* P = (const bf16_t*)(kws() + WS_P);
    bf16_t* Q0 = (bf16_t*)((unsigned char*)kout() + DO_Q0); bf16_t* KALL = (bf16_t*)(kws() + WS_KALL); bf16_t* VALL = (bf16_t*)(kws() + WS_VALL);
    bf16_t* XR = (bf16_t*)(kws() + WS_XR); bf16_t* XK = (bf16_t*)(kws() + WS_XK); bf16_t* XV = (bf16_t*)(kws() + WS_XV); bf16_t* KK = (bf16_t*)(kws() + WS_KK); bf16_t* AP = (bf16_t*)(kws() + WS_AP);
    float muv[7][8], kkc[2][8], qn[8], kn[8];
    { const float* mu = kin(9); const float* k_k = kin(19); const float* qnp = kin(24); const float* knp = kin(25);
#pragma unroll
      for (int p = 0; p < 7; ++p)
#pragma unroll
          for (int e = 0; e < 8; ++e) { const int c = p * 512 + lane * 8 + e; muv[p][e] = c < 3488 ? mu[c] : 0.f; }
#pragma unroll
      for (int p = 0; p < 2; ++p)
#pragma unroll
          for (int e = 0; e < 8; ++e) kkc[p][e] = k_k[p * 512 + lane * 8 + e];
#pragma unroll
      for (int e = 0; e < 8; ++e) { qn[e] = qnp[l7 * 8 + e]; kn[e] = knp[l7 * 8 + e]; } }
    for (int row = gw; row < NT; row += NGW) {
        const bf16_t* prow = P + (size_t)row * INP;
        const bool isc = row >= NLAT; int b, t = 0, s = 0, grow = 0, gcol = 0;
        if (!isc) { b = row >> 12; t = row & 4095; grow = t >> 6; gcol = t & 63; } else { b = (row - NLAT) >> 8; s = (row - NLAT) & 255; }
        float cs[8], sn[8];
#pragma unroll
        for (int e = 0; e < 8; ++e) { cs[e] = 1.f; sn[e] = 0.f; }
        if (!isc) {
#pragma unroll
            for (int e = 0; e < 8; ++e) { const int i = 8 * (l7 & 3) + e, mm = i & 15; const float pos = (float)(i < 16 ? grow : gcol); const float ang = pos * exp2f(-(float)mm * 0.8304820237218406f); cs[e] = cosf(ang); sn[e] = sinf(ang); } }
        const int kvpos = isc ? SEQ + s : t;
#pragma unroll
        for (int p = 0; p < 3; ++p) {
            const u32x4 raw = *(const u32x4*)(prow + p * 512 + lane * 8); float x[8]; unpack8(raw, x);
            float ss = 0.f;
#pragma unroll
            for (int e = 0; e < 8; ++e) ss += x[e] * x[e];
            ss = red8(ss); const float rs = rsqrtf(ss * (1.f / 64.f) + 1e-6f);
            float y[8];
#pragma unroll
            for (int e = 0; e < 8; ++e) y[e] = x[e] * rs * (p < 2 ? qn[e] : kn[e]);
            if (!isc) {
#pragma unroll
                for (int e = 0; e < 8; ++e) { const float o = __shfl_xor(y[e], 4); y[e] = (l7 < 4) ? y[e] * cs[e] - o * sn[e] : y[e] * cs[e] + o * sn[e]; } }
            if (p < 2) {
#pragma unroll
                for (int e = 0; e < 8; ++e) y[e] *= 0.125f * LOG2E;
                *(u32x4*)(Q0 + (size_t)row * 1024 + p * 512 + lane * 8) = pack8(y);
            } else {
                const size_t kvo = ((size_t)(b * 4 + ((lane >> 3) & 3)) * KVLEN + kvpos) * 64 + l7 * 8;
                if (lane < 32) *(u32x4*)(KALL + kvo) = pack8(y);
                else *(u32x4*)(VALL + kvo) = raw;
            }
        }
        bool val[4]; const bf16_t* nrw[4];
        if (!isc) { val[0] = gcol > 0; val[1] = gcol < 63; val[2] = grow > 0; val[3] = grow < 63; nrw[0] = prow - INP; nrw[1] = prow + INP; nrw[2] = prow - 64 * INP; nrw[3] = prow + 64 * INP; }
        else { val[0] = val[2] = s > 0; val[1] = val[3] = s < 255; nrw[0] = nrw[2] = prow - INP; nrw[1] = nrw[3] = prow + INP; }
#pragma unroll
        for (int p = 0; p < 7; ++p) {
            const int c0 = 1536 + p * 512 + lane * 8;
            float cur[8], nb[4][8];
            unpack8(*(const u32x4*)(prow + c0), cur);
#pragma unroll
            for (int d = 0; d < 4; ++d) { u32x4 nv = (u32x4){0u, 0u, 0u, 0u}; if (val[d]) nv = *(const u32x4*)(nrw[d] + c0); unpack8(nv, nb[d]); }
            float xm[8];
#pragma unroll
            for (int e = 0; e < 8; ++e) xm[e] = cur[e] + muv[p][e] * (nb[e & 3][e] - cur[e]);
            if (p < 2) *(u32x4*)(XR + (size_t)row * 1024 + p * 512 + lane * 8) = pack8(xm);
            else if (p < 4) { *(u32x4*)(XK + (size_t)row * 1024 + (p - 2) * 512 + lane * 8) = pack8(xm);
                float t2[8]; float ss = 0.f;
#pragma unroll
                for (int e = 0; e < 8; ++e) { t2[e] = xm[e] * kkc[p - 2][e]; ss += t2[e] * t2[e]; }
                ss = red8(ss); const float rs = rsqrtf(fmaxf(ss, 1e-12f));
#pragma unroll
                for (int e = 0; e < 8; ++e) t2[e] *= rs;
                *(u32x4*)(KK + (size_t)row * 1024 + (p - 2) * 512 + lane * 8) = pack8(t2); }
            else if (p < 6) *(u32x4*)(XV + (size_t)row * 1024 + (p - 4) * 512 + lane * 8) = pack8(xm);
            else { float o[8]; const int a0 = lane * 8;
#pragma unroll
                for (int e = 0; e < 8; ++e) o[e] = a0 < 128 ? tanhf(xm[e]) : a0 < 256 ? xm[e] : a0 < 416 ? sigm(xm[e]) : 0.f;
                *(u32x4*)(AP + (size_t)row * 512 + a0) = pack8(o); }
        }
    }
}

__device__ __forceinline__ void phase_finish0() {
    const int tid = tidx(), lane = tid & 63, wid = tid >> 6; const int gw = blockIdx.x * 8 + wid, NGW = gridDim.x * 8;
    const bf16_t* YF = (const bf16_t*)((unsigned char*)kout() + DO_YF); const bf16_t* YB = (const bf16_t*)((unsigned char*)kout() + DO_YB);
    const bf16_t* XR = (const bf16_t*)(kws() + WS_XR); const bf16_t* XK = (const bf16_t*)(kws() + WS_XK); const bf16_t* XV = (const bf16_t*)(kws() + WS_XV);
    const bf16_t* Z = (const bf16_t*)(kws() + WS_P); bf16_t* OC = (bf16_t*)(kws() + WS_H);
    float kac[2][8], rkc[2][8], lgc[2][8], lbc[2][8];
    { const float* k_a = kin(20); const float* r_k = kin(21); const float* lg = kin(22); const float* lb = kin(23);
#pragma unroll
      for (int p = 0; p < 2; ++p)
#pragma unroll
          for (int e = 0; e < 8; ++e) { const int c = p * 512 + lane * 8 + e; kac[p][e] = k_a[c]; rkc[p][e] = r_k[c]; lgc[p][e] = lg[c]; lbc[p][e] = lb[c]; } }
    for (int row = gw; row < NT; row += NGW) {
#pragma unroll
        for (int p = 0; p < 2; ++p) { const int c0 = p * 512 + lane * 8; const size_t o = (size_t)row * 1024 + c0; const bf16_t* zr = Z + (size_t)row * INP + c0;
            float yf[8], yb[8], r[8], k[8], v[8], icf[8], icb[8], gt[8];
            unpack8(__builtin_nontemporal_load((const u32x4*)(YF + o)), yf); unpack8(__builtin_nontemporal_load((const u32x4*)(YB + o)), yb); unpack8(__builtin_nontemporal_load((const u32x4*)(XR + o)), r); unpack8(__builtin_nontemporal_load((const u32x4*)(XK + o)), k); unpack8(__builtin_nontemporal_load((const u32x4*)(XV + o)), v);
            unpack8(__builtin_nontemporal_load((const u32x4*)(zr + 2048)), icf); unpack8(__builtin_nontemporal_load((const u32x4*)(zr + 3072)), icb); unpack8(__builtin_nontemporal_load((const u32x4*)(zr + 4096)), gt);
            float y[8], sm = 0.f, bs = 0.f;
#pragma unroll
            for (int e = 0; e < 8; ++e) { y[e] = yf[e] + yb[e]; sm += y[e]; bs += r[e] * k[e] * (2.f + (icf[e] + icb[e] - 2.f) * kac[p][e]) * rkc[p][e]; }
            const float mean = red8(sm) * (1.f / 64.f); bs = red8(bs); float vs = 0.f;
#pragma unroll
            for (int e = 0; e < 8; ++e) { y[e] -= mean; vs += y[e] * y[e]; }
            const float rstd = rsqrtf(red8(vs) * (1.f / 64.f) + 64e-5f); float ov[8];
#pragma unroll
            for (int e = 0; e < 8; ++e) ov[e] = (y[e] * rstd * lgc[p][e] + lbc[p][e] + bs * v[e]) * gt[e];
            *(u32x4*)(OC + (size_t)row * 2048 + 1024 + c0) = pack8(ov); }
    }
}

__device__ __forceinline__ float allred8(float x) {
    x += dppf<0x128>(x);
    auto s = __builtin_amdgcn_permlane16_swap(__float_as_uint(x), __float_as_uint(x), false, false); x = __uint_as_float(s[0]) + __uint_as_float(s[1]);
    auto t = __builtin_amdgcn_permlane32_swap(__float_as_uint(x), __float_as_uint(x), false, false); return __uint_as_float(t[0]) + __uint_as_float(t[1]);
}
__device__ __forceinline__ float allred4(float x) {
    auto s = __builtin_amdgcn_permlane16_swap(__float_as_uint(x), __float_as_uint(x), false, false); x = __uint_as_float(s[0]) + __uint_as_float(s[1]);
    auto t = __builtin_amdgcn_permlane32_swap(__float_as_uint(x), __float_as_uint(x), false, false); return __uint_as_float(t[0]) + __uint_as_float(t[1]);
}
__device__ __forceinline__ void scan_block(unsigned char* shm, int sid, int half) {
    const int tid = tidx(), lane = tid & 63, wid = __builtin_amdgcn_readfirstlane(tid >> 6), nr = lane >> 4, g = lane & 15, rowl = wid * 4 + nr;
    const int dir = sid >> 6, b = (sid >> 4) & 3, h = sid & 15;
    const bf16_t* XR = (const bf16_t*)(kws() + WS_XR); const bf16_t* XK = (const bf16_t*)(kws() + WS_XK); const bf16_t* XV = (const bf16_t*)(kws() + WS_XV); const bf16_t* KK = (const bf16_t*)(kws() + WS_KK);
    const bf16_t* Z = (const bf16_t*)(kws() + WS_P);
    bf16_t* Y = (bf16_t*)((unsigned char*)kout() + (dir ? DO_YB : DO_YF));
    constexpr int TS = 32, NCH = (CTX + SEQ) / TS;
    float* bufs = (float*)shm;
    float* yst = (float*)(shm + 98304);
    const int ss = tid >> 4, part = tid & 15;
    float ka[4];
#pragma unroll
    for (int e = 0; e < 4; ++e) ka[e] = kin(20)[h * 64 + 4 * part + e];
    u32x2 lr, lk, lv, lkk, le, li;
#define SCAN_ROW(gs) ((gs) < CTX ? (NLAT + b * CTX + (dir ? CTX - 1 - (gs) : (gs))) : (b * SEQ + (dir ? SEQ - 1 - ((gs) - CTX) : ((gs) - CTX))))
#define SCAN_LOAD(c) do { const int row_ = SCAN_ROW((c) * TS + ss); const size_t o_ = (size_t)row_ * 1024 + h * 64 + 4 * part; const size_t z_ = (size_t)row_ * INP + dir * 1024 + h * 64 + 4 * part; \
        lr = *(const u32x2*)(XR + o_); lk = *(const u32x2*)(XK + o_); lv = *(const u32x2*)(XV + o_); lkk = *(const u32x2*)(KK + o_); le = *(const u32x2*)(Z + z_); li = *(const u32x2*)(Z + z_ + 2048); } while (0)
#define BFLO(u) __uint_as_float((u) << 16)
#define BFHI(u) __uint_as_float((u) & 0xffff0000u)
#define SCAN_STORE(c) do { float* bb_ = bufs + ((c) & 1) * 12288 + ss * 64 + 4 * part; \
        const f32x4 r_ = {BFLO(lr.x), BFHI(lr.x), BFLO(lr.y), BFHI(lr.y)}, k_ = {BFLO(lk.x), BFHI(lk.x), BFLO(lk.y), BFHI(lk.y)}, v_ = {BFLO(lv.x), BFHI(lv.x), BFLO(lv.y), BFHI(lv.y)}; \
        const f32x4 kk_ = {BFLO(lkk.x), BFHI(lkk.x), BFLO(lkk.y), BFHI(lkk.y)}, e_ = {BFLO(le.x), BFHI(le.x), BFLO(le.y), BFHI(le.y)}, i_ = {BFLO(li.x), BFHI(li.x), BFLO(li.y), BFHI(li.y)}; \
        const f32x4 kav_ = {ka[0], ka[1], ka[2], ka[3]}; \
        *(f32x4*)(bb_ + 0 * 2048) = 1.f - e_; *(f32x4*)(bb_ + 1 * 2048) = -kk_; *(f32x4*)(bb_ + 2 * 2048) = kk_ * i_; \
        *(f32x4*)(bb_ + 3 * 2048) = k_ * ((i_ - 1.f) * kav_ + 1.f); *(f32x4*)(bb_ + 4 * 2048) = r_; *(f32x4*)(bb_ + 5 * 2048) = v_; } while (0)
    SCAN_LOAD(0); SCAN_STORE(0);
    __syncthreads();
    float S[4] = {0.f, 0.f, 0.f, 0.f};
    for (int c = 0; c < NCH; ++c) {
        if (c + 1 < NCH) SCAN_LOAD(c + 1);
        { const float* bb = bufs + (c & 1) * 12288 + 4 * g; float* ys = yst + (c & 1) * 1024 + rowl; const float* vb = bufs + (c & 1) * 12288 + 5 * 2048 + half * 32 + rowl;
          f32x4 w4[3], a4[3], b4[3], k4[3], r4[3]; float vv[3];
#define LDOPS(s_) do { const float* p_ = bb + (s_) * 64; w4[(s_) % 3] = *(const f32x4*)(p_); a4[(s_) % 3] = *(const f32x4*)(p_ + 2048); b4[(s_) % 3] = *(const f32x4*)(p_ + 4096); k4[(s_) % 3] = *(const f32x4*)(p_ + 6144); \
              r4[(s_) % 3] = *(const f32x4*)(p_ + 8192); vv[(s_) % 3] = vb[(s_) * 64]; } while (0)
          LDOPS(0); LDOPS(1);
#pragma unroll
          for (int s = 0; s < TS; ++s) {
              const f32x4 a_ = a4[s % 3], w_ = w4[s % 3], b_ = b4[s % 3], k_ = k4[s % 3], r_ = r4[s % 3];
              const float av[4] = {a_.x, a_.y, a_.z, a_.w}, wv[4] = {w_.x, w_.y, w_.z, w_.w}, bv[4] = {b_.x, b_.y, b_.z, b_.w}, kv[4] = {k_.x, k_.y, k_.z, k_.w}, rv[4] = {r_.x, r_.y, r_.z, r_.w};
              const float v1 = vv[s % 3];
              if (s + 2 < TS) LDOPS(s + 2);
              float t = S[0] * av[0]; t = fmaf(S[1], av[1], t); t = fmaf(S[2], av[2], t); t = fmaf(S[3], av[3], t);
              t += dppf<0xB1>(t); t += dppf<0x4E>(t); t += dppf<0x141>(t); t += dppf<0x140>(t);
#pragma unroll
              for (int q = 0; q < 4; ++q) S[q] = fmaf(S[q], wv[q], fmaf(bv[q], t, kv[q] * v1));
              float u = S[0] * rv[0]; u = fmaf(S[1], rv[1], u); u = fmaf(S[2], rv[2], u); u = fmaf(S[3], rv[3], u);
              u += dppf<0xB1>(u); u += dppf<0x4E>(u); u += dppf<0x141>(u); u += dppf<0x140>(u);
              ys[s * 32] = u;
          }
#undef LDOPS
        }
        if (c + 1 < NCH) SCAN_STORE(c + 1);
        __syncthreads();
        { const f32x2 yv = *(const f32x2*)(yst + (c & 1) * 1024 + ss * 32 + 2 * part); const int row_ = SCAN_ROW(c * TS + ss);
          *(unsigned*)(Y + (size_t)row_ * 1024 + h * 64 + half * 32 + 2 * part) = pk2(yv.x, yv.y); }
    }
    __syncthreads();
#undef SCAN_ROW
#undef SCAN_LOAD
#undef SCAN_STORE
#undef BFLO
#undef BFHI
}

constexpr int AT_K = 0, AT_V = 16384, AT_WS = 32768, AT_OST = 34816, AT_RPB = 67584, AT_Q = 90112;
struct NaInfo { int i0, R0, nW; size_t latbase, ctxbase; };
template <int MODE> __device__ __forceinline__ void attn_unit(unsigned char* shmu, const bf16_t* Qw, int qpitch, const bf16_t* Kb, const bf16_t* Vb, int kvpitch, int ntiles,
                                                              bf16_t* Ow, int opitch, const NaInfo na) {
    using namespace att;
    char* shm = (char*)shmu;
    const int tid = tidx(), lane = tid & 63, r32 = lane & 31, hi = lane >> 5; const int wid = __builtin_amdgcn_readfirstlane(tid >> 6);
    bf16x8 qr[4];
#pragma unroll
    for (int d0 = 0; d0 < 4; ++d0) qr[d0] = *reinterpret_cast<const bf16x8*>(Qw + (size_t)r32 * qpitch + d0 * 16 + hi * 8);
    float* wsf = (float*)(shm + AT_WS) + wid * 64;
    const float* rpbs = (const float*)(shm + AT_RPB);
    const unsigned lds0 = (unsigned)(uintptr_t)shm;
    const int vb0 = (int)(lds0 + AT_V) + ((lane >> 4) & 1) * 32 + (lane & 3) * 8 + (4 * hi + ((lane & 15) >> 2)) * 64;
    const int kkey = lane, kch = wid;
    const int vkey = 16 * (wid & 3) + (lane >> 2), vd = (wid >> 2) * 32 + (lane & 3) * 8;
    const int sdst = wid * 1024 + lane * 16;
#define AT_ROWOFF(t) (MODE == 0 ? (size_t)(t) * 64 : ((t) < na.nW ? na.latbase + (size_t)(na.R0 + (t)) * 64 : na.ctxbase + (size_t)((t) - na.nW) * 64))
    u32x4 kreg, vreg;
    { const size_t ro = AT_ROWOFF(0); kreg = *(const u32x4*)(Kb + (ro + kkey) * kvpitch + kch * 8); vreg = *(const u32x4*)(Vb + (ro + vkey) * kvpitch + vd); }
    *(u32x4*)(shm + AT_K + sdst) = kreg; *(u32x4*)(shm + AT_V + sdst) = vreg;
    __syncthreads();
    float m_run = -1e30f, l_run = 0.f; f32x16 o[2]; o[0] = f32x16{}; o[1] = f32x16{};
    const f32x16 zero16 = f32x16{};
    const int qi = na.i0 + (wid >> 1), qc = 32 * (wid & 1) + r32; const int rs = min(max(qi - 4, 0), 56), csn = min(max(qc - 8, 0), 48);
    for (int t = 0; t < ntiles; ++t) {
        if (t + 1 < ntiles) { const size_t ro = AT_ROWOFF(t + 1); kreg = *(const u32x4*)(Kb + (ro + kkey) * kvpitch + kch * 8); vreg = *(const u32x4*)(Vb + (ro + vkey) * kvpitch + vd); }
        bool rel = true; int krow = 0;
        if (MODE == 1 && t < na.nW) { krow = na.R0 + t; rel = (krow >= rs) && (krow <= rs + 7); }
        if (rel) {
            f32x16 p0, p1;
            qkt(p0, p1, shm + AT_K + (t & 1) * 8192, qr, zero16, r32, hi);
            if (MODE == 1 && t < na.nW) { const int dr = (krow - qi + 7) * 31 + 15 - qc;
#pragma unroll
                for (int r = 0; r < 16; ++r) { const int kc0 = crow(r, hi), kc1 = kc0 + 32;
                    const bool v0 = (kc0 >= csn) && (kc0 < csn + 16), v1 = (kc1 >= csn) && (kc1 < csn + 16);
                    const float b0 = rpbs[v0 ? dr + kc0 : 0], b1 = rpbs[v1 ? dr + kc1 : 0];
                    p0[r] = v0 ? p0[r] + b0 : -1e30f; p1[r] = v1 ? p1[r] + b1 : -1e30f; } }
            const float rm = rowmax(p0, p1);
            const float m_new = fmaxf(m_run, rm); const float alpha = __builtin_amdgcn_exp2f(m_run - m_new); m_run = m_new;
            float sacc = 0.f;
#pragma unroll
            for (int r = 0; r < 16; ++r) { p0[r] = __builtin_amdgcn_exp2f(p0[r] - m_new); p1[r] = __builtin_amdgcn_exp2f(p1[r] - m_new); sacc += p0[r] + p1[r]; }
            l_run = l_run * alpha + sacc;
            if (hi == 0) wsf[r32] = alpha;
            asm volatile("s_waitcnt lgkmcnt(0)" ::: "memory");
#pragma unroll
            for (int r = 0; r < 16; ++r) { const float f = wsf[crow(r, hi)]; o[0][r] *= f; o[1][r] *= f; }
            u32x4 pw0, pw1, pw2, pw3;
            pw0 = (u32x4){cvtpk_s(p0[0], p0[1]), cvtpk_s(p0[2], p0[3]), cvtpk_s(p0[4], p0[5]), cvtpk_s(p0[6], p0[7])};
            pw1 = (u32x4){cvtpk_s(p0[8], p0[9]), cvtpk_s(p0[10], p0[11]), cvtpk_s(p0[12], p0[13]), cvtpk_s(p0[14], p0[15])};
            pw2 = (u32x4){cvtpk_s(p1[0], p1[1]), cvtpk_s(p1[2], p1[3]), cvtpk_s(p1[4], p1[5]), cvtpk_s(p1[6], p1[7])};
            pw3 = (u32x4){cvtpk_s(p1[8], p1[9]), cvtpk_s(p1[10], p1[11]), cvtpk_s(p1[12], p1[13]), cvtpk_s(p1[14], p1[15])};
            pv(o, vb0 + (t & 1) * 8192, __builtin_bit_cast(bf16x8, pw0), __builtin_bit_cast(bf16x8, pw1), __builtin_bit_cast(bf16x8, pw2), __builtin_bit_cast(bf16x8, pw3));
        }
        if (t + 1 < ntiles) { *(u32x4*)(shm + AT_K + ((t + 1) & 1) * 8192 + sdst) = kreg; *(u32x4*)(shm + AT_V + ((t + 1) & 1) * 8192 + sdst) = vreg; }
        __syncthreads();
    }
    { auto rr = __builtin_amdgcn_permlane32_swap(__float_as_uint(l_run), __float_as_uint(l_run), false, false); l_run = __uint_as_float(rr[0]) + __uint_as_float(rr[1]); }
    if (hi == 0) wsf[32 + r32] = l_run;
    asm volatile("s_waitcnt lgkmcnt(0)" ::: "memory");
    float rli[16];
#pragma unroll
    for (int r = 0; r < 16; ++r) rli[r] = __builtin_amdgcn_rcpf(wsf[32 + crow(r, hi)]);
    { bf16_t* stg = (bf16_t*)(shm + AT_OST) + wid * 2048;
#pragma unroll
      for (int r = 0; r < 16; ++r) { const int orow = crow(r, hi);
#pragma unroll
          for (int d0 = 0; d0 < 2; ++d0) stg[orow * 64 + d0 * 32 + r32] = (bf16_t)f2bf(o[d0][r] * rli[r]); }
      asm volatile("s_waitcnt lgkmcnt(0)" ::: "memory");
#pragma unroll
      for (int i = 0; i < 4; ++i) { const int row = i * 8 + (lane >> 3), ch = lane & 7; const u32x4 v = *(const u32x4*)(stg + row * 64 + ch * 8); *(u32x4*)(Ow + (size_t)row * opitch + ch * 8) = v; } }
    __syncthreads();
#undef AT_ROWOFF
}

__device__ __forceinline__ void phase_mix0(unsigned char* shm, int ctrw) {
#ifndef SCANREP
#define SCANREP 1
#endif
    for (int srep = 0; srep < SCANREP; ++srep)
    for (int hs = blockIdx.x; hs < 256; hs += gridDim.x) { const int x8 = hs & 7, slot = hs >> 3; scan_block(shm, (x8 >> 2) * 64 + (x8 & 3) * 16 + (slot >> 1), slot & 1); }
#ifndef QREP
#define QREP 1
#endif
    for (int qrep = 0; qrep < QREP; ++qrep) {
    unsigned* ctr = (unsigned*)(kws() + WS_CTL) + ctrw + 16 * qrep;
    const bf16_t* Q0 = (const bf16_t*)((unsigned char*)kout() + DO_Q0); const bf16_t* KALL = (const bf16_t*)(kws() + WS_KALL); const bf16_t* VALL = (const bf16_t*)(kws() + WS_VALL);
    bf16_t* OC = (bf16_t*)(kws() + WS_H);
    const int wid = tidx() >> 6; const NaInfo na{0, 0, 0, 0, 0};
    for (;;) {
        if (tidx() == 0) *(volatile unsigned*)(shm + AT_Q) = atomicAdd(ctr, 1u);
        __syncthreads();
        const unsigned u = *(volatile unsigned*)(shm + AT_Q);
        __syncthreads();
        if (u >= 1088u + (unsigned)(TQ_ITEMS / 64)) break;
        if (u >= 1088u) { const int base = (int)(u - 1088u) * 64; float* scr = (float*)(shm + wid * 8448); const int lane = tidx() & 63;
            for (int e = 0; e < 8; ++e) transpose_deferred(base + e * 8 + wid, scr, lane);
            __syncthreads(); continue; }
        if (u < 1024u) { const int b = u >> 8, hq = (u >> 4) & 15, qb = u & 15, kvh = hq >> 2; const size_t qrow = (size_t)b * SEQ + qb * 256 + wid * 32;
            att::attn_unit_p<8>((const att::bf16*)(Q0 + (qrow - wid * 32) * 1024 + hq * 64), 1024, (const att::bf16*)(KALL + (size_t)(b * 4 + kvh) * KVLEN * 64), (const att::bf16*)(VALL + (size_t)(b * 4 + kvh) * KVLEN * 64), 64, KVLEN / 64, (att::bf16*)(OC + (qrow - wid * 32) * 2048 + hq * 64), 2048, (char*)shm); }
        else { const int cu = u - 1024, b = cu >> 4, hq = cu & 15, kvh = hq >> 2; const size_t qrow = (size_t)NLAT + b * CTX + wid * 32;
            att::attn_unit_p<8>((const att::bf16*)(Q0 + (qrow - wid * 32) * 1024 + hq * 64), 1024, (const att::bf16*)(KALL + ((size_t)(b * 4 + kvh) * KVLEN + SEQ) * 64), (const att::bf16*)(VALL + ((size_t)(b * 4 + kvh) * KVLEN + SEQ) * 64), 64, CTX / 64, (att::bf16*)(OC + (qrow - wid * 32) * 2048 + hq * 64), 2048, (char*)shm); }
    }
    }
}
__device__ __forceinline__ void phase_mix1(unsigned char* shm) {
    const bf16_t* Q1 = (const bf16_t*)(kws() + WS_Q1); const bf16_t* K1 = (const bf16_t*)(kws() + WS_K1); const bf16_t* V1 = (const bf16_t*)(kws() + WS_V1); bf16_t* O1 = (bf16_t*)(kws() + WS_O1);
    const float* rpb = kin(34);
    float* rp = (float*)(shm + 86016);
    const bool fixed_head = gridDim.x == 256; int h_loaded = -1;
    for (int k = 0, u = blockIdx.x; u < 2048; ++k, u += gridDim.x) {
        int rb, h, b;
        if (fixed_head) { h = blockIdx.x & 31; const int rest = (blockIdx.x >> 5) + 8 * k; b = rest >> 4; rb = rest & 15; } else { rb = u & 15; h = (u >> 4) & 31; b = u >> 9; }
        const int i0 = rb * 4;
        if (h != h_loaded) { __syncthreads(); for (int i = tidx(); i < 465; i += 512) rp[i] = rpb[h * 465 + i] * LOG2E; h_loaded = h; }
        __syncthreads();
        att::NaP na; na.i0 = i0; na.R0 = min(max(i0 - 4, 0), 56); const int R1 = min(max(i0 + 3 - 4, 0), 56) + 7; na.nW = R1 - na.R0 + 1; na.rpbs = rp;
        const size_t latrow0 = (size_t)b * SEQ + (size_t)na.R0 * 64, ctxrow0 = (size_t)NLAT + b * CTX;
        na.jump = (long)ctxrow0 - (long)(latrow0 + (size_t)na.nW * 64);
        const int NTt = (na.nW + 4 + 1) & ~1;
        const size_t qrow = (size_t)b * SEQ + (size_t)i0 * 64;
        att::attn_unit_na<8>((const att::bf16*)(Q1 + qrow * 2048 + h * 64), 2048, (const att::bf16*)(K1 + latrow0 * 2048 + h * 64), (const att::bf16*)(V1 + latrow0 * 2048 + h * 64), 2048, NTt,
                             (att::bf16*)(O1 + qrow * 2048 + h * 64), 2048, (char*)shm, na);
        __syncthreads();
    }
}
__device__ __forceinline__ int opq(int v) { asm volatile("" : "+s"(v)); return v; }
#ifdef SYNC2
#define GSYNC() do { xcd_barrier(xbar); xcd_barrier(xbar); } while (0)
#else
#define GSYNC() xcd_barrier(xbar)
#endif
#ifndef DUPMASK
#define DUPMASK 0u
#endif
#define REP(k) for (int rep_ = 0; rep_ < 1 + (int)((DUPMASK >> (k)) & 1u); ++rep_)
__global__ void __launch_bounds__(512, 2) fwd_megakernel(Args a) {
    extern __shared__ __attribute__((aligned(16))) unsigned char lds[];
    cg::grid_group grid = cg::this_grid();
    { volatile LAS unsigned* st0 = (volatile LAS unsigned*)((LAS unsigned char*)lds + (LDS_BYTES - 64)); if (tidx() == 0) { st0[0] = 0u; st0[1] = 0u; } }
    __syncthreads();
    const XcdBarrier xbar = xcd_barrier_post((unsigned*)(kws() + WS_CTL) + 4096, (volatile LAS unsigned*)((LAS unsigned char*)lds + (LDS_BYTES - 64)));
#define G opq(gridDim.x)
#define c opq(blockIdx.x)
#define ws kws()
#define XIN kin(0)
#define CIN kin(2)
#define mod ((float*)(kws() + WS_MOD))
#define ctxr ((float*)(kws() + WS_CTXR))
#define H ((bf16_t*)(kws() + WS_H))
#define mod1 (mod + 5 * 12288)
    PG8_LAS unsigned char* glds = (PG8_LAS unsigned char*)lds;
    if (gridDim.y == 0x7fffu) grid.sync();
    REP(0) { phase_prologue(lds);
    GSYNC(); }
    REP(5) { phase_norm_mod(XIN, CIN, kin(4), mod + 0, mod + 2048, H, NT);
    GSYNC(); }
    { pg8::Gemm g{H, (const bf16_t*)(ws + WS_WIN), NT, INP, DM, DM}; pg8::StaticOrder S; S.init(NT, INP, G, c);
      pg8::EpiBf16<0> E{(bf16_t*)(ws + WS_P), INP, 0, 0, 1.f, nullptr};
      pg8::gemm_phase<pg8::EpiBf16<0>, pg8::StaticOrder, true, true>(glds, g, S, E); }
    GSYNC();
    REP(1) { phase_prep0();
    GSYNC(); }
    { pg8::Gemm g{(const bf16_t*)(ws + WS_AP), (const bf16_t*)(ws + WS_BP), NT, INP, 512, 256}; pg8::SliceOrder S; S.init(NT, INP, G, c); S.pn1 = 16;
      pg8::EpiBf16<3> E{(bf16_t*)(ws + WS_P), INP, 0, 0, 1.f, (const float*)(kws() + WS_ZB)};
      pg8::gemm_phase<pg8::EpiBf16<3>, pg8::SliceOrder, true, true>(glds, g, S, E); }
    GSYNC();
    REP(2) { phase_mix0(lds, 64 + 64 * rep_);
    GSYNC(); }
    REP(3) { phase_finish0();
    GSYNC(); }
    { pg8::Gemm g{H, (const bf16_t*)(ws + WS_WO0), NT, DM, DM, DM}; pg8::StaticOrder S; S.init(NT, DM, G, c);
      pg8::EpiResidB<false> E{XIN, (bf16_t*)(ws + WS_XRB), CIN, (bf16_t*)(ws + WS_XRB), ctxr, mod + 4096};
      pg8::gemm_phase<pg8::EpiResidB<false>, pg8::StaticOrder, true, true>(glds, g, S, E); }
    GSYNC();
    phase_norm_mod(kout(), ctxr, kin(5), mod + 6144, mod + 8192, H, NT, nullptr, nullptr, (bf16_t*)(ws + WS_XRB));
    GSYNC();
    REP(6)
    { pg8::Gemm g{H, (const bf16_t*)(ws + WS_W10), NT, 8192, DM, DM}; pg8::StaticOrder S; S.init(NT, 8192, G, c);
      pg8::EpiBf16<2> E{(bf16_t*)(ws + WS_U), 8192, 0, 0, 1.f, nullptr};
      pg8::gemm_phase<pg8::EpiBf16<2>, pg8::StaticOrder, true, true>(glds, g, S, E); }
    GSYNC();
    { pg8::Gemm g{(const bf16_t*)(ws + WS_U), (const bf16_t*)(ws + WS_W20), NLAT, DM, 8192, 8192}; pg8::StaticOrder S; S.init(NLAT, DM, G, c);
      pg8::EpiResidB<true> E{XIN, (bf16_t*)(ws + WS_XRB), ctxr, (bf16_t*)(ws + WS_XRB), ctxr, mod + 10240};
      pg8::gemm_phase<pg8::EpiResidB<true>, pg8::StaticOrder, true, true>(glds, g, S, E); }
    { pg8::Gemm g{(const bf16_t*)(ws + WS_U) + (size_t)NLAT * 8192, (const bf16_t*)(ws + WS_W20), NCTX, DM, 8192, 1024}; pg8::SplitOrder S; S.init(NCTX, DM, 8, G, c);
      pg8::EpiPartial E{(float*)(ws + WS_PART)};
      pg8::gemm_phase<pg8::EpiPartial, pg8::SplitOrder, true, true>(glds, g, S, E); }
    GSYNC();
    phase_norm_mod(kout(), ctxr, kin(29), mod1 + 0, mod1 + 2048, H, NT, (const float*)(ws + WS_PART), mod + 10240, (bf16_t*)(ws + WS_XRB));
    GSYNC();
    { pg8::Gemm g{H, (const bf16_t*)(ws + WS_WQKV), NT, 6144, DM, DM}; pg8::StaticOrder S; S.init(NT, 6144, G, c);
      pg8::EpiBf16<0> E{(bf16_t*)(ws + WS_Q1), 2048, 2048, (size_t)(WS_K1 - WS_Q1) / 2, 0.125f * LOG2E, nullptr};
      pg8::gemm_phase<pg8::EpiBf16<0>, pg8::StaticOrder, true, true>(glds, g, S, E); }
    GSYNC();
    REP(4) { phase_mix1(lds);
    GSYNC(); }
    { pg8::Gemm g{(const bf16_t*)(ws + WS_O1), (const bf16_t*)(ws + WS_WO1), NLAT, DM, DM, DM}; pg8::StaticOrder S; S.init(NLAT, DM, G, c);
      pg8::EpiResidB<true> E{XIN, (bf16_t*)(ws + WS_XRB), ctxr, (bf16_t*)(ws + WS_XRB), ctxr, mod1 + 4096};
      pg8::gemm_phase<pg8::EpiResidB<true>, pg8::StaticOrder, true, true>(glds, g, S, E); }
    GSYNC();
    phase_norm_mod(kout(), ctxr, kin(30), mod1 + 6144, mod1 + 8192, H, NLAT, nullptr, nullptr, (bf16_t*)(ws + WS_XRB));
    GSYNC();
    { pg8::Gemm g{H, (const bf16_t*)(ws + WS_W11), NLAT, 8192, DM, DM}; pg8::StaticOrder S; S.init(NLAT, 8192, G, c);
      pg8::EpiBf16<2> E{(bf16_t*)(ws + WS_U), 8192, 0, 0, 1.f, nullptr};
      pg8::gemm_phase<pg8::EpiBf16<2>, pg8::StaticOrder, true, true>(glds, g, S, E); }
    GSYNC();
    { pg8::Gemm g{(const bf16_t*)(ws + WS_U), (const bf16_t*)(ws + WS_W21), NLAT, DM, 8192, 8192}; pg8::StaticOrder S; S.init(NLAT, DM, G, c);
      pg8::EpiResidB<true> E{XIN, (bf16_t*)(ws + WS_XRB), ctxr, (bf16_t*)(ws + WS_XRB), ctxr, mod1 + 10240};
      pg8::gemm_phase<pg8::EpiResidB<true>, pg8::StaticOrder, true, true>(glds, g, S, E); }
    GSYNC();
    phase_final_norm(kout(), kin(38), NLAT, (bf16_t*)(ws + WS_XRB));
#undef G
#undef c
#undef ws
#undef XIN
#undef CIN
#undef mod
#undef ctxr
#undef H
#undef mod1
}

extern "C" void kernel_launch(void* const* d_in, const int* in_sizes, int n_in, void* d_out, int out_size, void* d_ws, size_t ws_size, hipStream_t stream) {
    static int grid = 0;
    if (grid == 0) {
        if (n_in != 39 || out_size != NLAT * DM || ws_size < WS_END) { fprintf(stderr, "kernel_launch: unexpected shapes (n_in %d out %d ws %zu)\n", n_in, out_size, ws_size); grid = -1; return; }
        int dev = 0, cus = 0, per = 0;
        (void)hipGetDevice(&dev); (void)hipDeviceGetAttribute(&cus, hipDeviceAttributeMultiprocessorCount, dev);
        (void)hipFuncSetAttribute((const void*)fwd_megakernel, hipFuncAttributeMaxDynamicSharedMemorySize, LDS_BYTES);
        (void)hipOccupancyMaxActiveBlocksPerMultiprocessor(&per, (const void*)fwd_megakernel, 512, LDS_BYTES);
        if (per < 1) per = 1;
        grid = cus * per;
        fprintf(stderr, "kernel_launch: grid %d (cus %d x %d), ws %zu\n", grid, cus, per, ws_size);
    }
    if (grid < 0) return;
    (void)hipMemsetAsync((char*)d_ws + WS_CTL, 0, 65536, stream);
    Args a{};
    for (int i = 0; i < 39; ++i) a.in[i] = (const float*)d_in[i];
    a.out = (float*)d_out; a.ws = (unsigned char*)d_ws; a.grid = grid; a.pad = 0;
    void* args[] = {&a};
    hipError_t e = hipLaunchCooperativeKernel((const void*)fwd_megakernel, dim3(grid), dim3(512), args, LDS_BYTES, stream);
    if (e != hipSuccess) fprintf(stderr, "kernel_launch: cooperative launch failed: %s (grid %d)\n", hipGetErrorString(e), grid);
}
```
